# Optimizing an MI355X kernel written in HIP

```python
import math
import jax, jax.numpy as jnp
from jax import lax
import numpy as np

D_MODEL = 4096
BATCH = 4
SEQ = 2048
DEPTH = 1

CHUNK = 64
Q_BLOCK = 128

MLA_HEADS = 16
MLA_NOPE_DIM = 128
MLA_ROPE_DIM = 64
MLA_V_DIM = 128
MLA_Q_LORA = 1024
MLA_KV_LORA = 512
ROPE_THETA = 10000.0
MLA_OUT_WIDTH = MLA_HEADS * MLA_V_DIM

HG_HEADS = 16
HG_K_DIM = 128
HG_V_DIM = 128
HG_BLOCK = 16
HG_WIDTH_K = HG_HEADS * HG_K_DIM
HG_WIDTH_V = HG_HEADS * HG_V_DIM

D_FF = -(-8 * D_MODEL // (3 * 256)) * 256

ALPHA = (2 * DEPTH) ** 0.25
BETA = (8 * DEPTH) ** -0.25
EPS = 1e-5

SPLITS = (MLA_Q_LORA, MLA_KV_LORA, MLA_ROPE_DIM,
          HG_WIDTH_K, HG_WIDTH_K, HG_WIDTH_V, HG_WIDTH_V,
          D_MODEL, D_MODEL)
IN_WIDTH = sum(SPLITS)

kernel_name = "mla_hgrn2_gated_hybrid_deepnorm"


def layer_norm(x, g, b):
    xf = x.astype(jnp.float32)
    mu = jnp.mean(xf, axis=-1, keepdims=True)
    var = jnp.mean(jnp.square(xf - mu), axis=-1, keepdims=True)
    return ((xf - mu) * lax.rsqrt(var + EPS) * g + b).astype(x.dtype)


def rms_norm(x, g):
    xf = x.astype(jnp.float32)
    ms = jnp.mean(jnp.square(xf), axis=-1, keepdims=True)
    return (xf * lax.rsqrt(ms + EPS) * g).astype(x.dtype)


def rope(x, positions):
    half = x.shape[-1] // 2
    inv_freq = ROPE_THETA ** (-jnp.arange(half, dtype=jnp.float32) / half)
    ang = positions[..., None].astype(jnp.float32) * inv_freq
    cos = jnp.cos(ang)[:, :, None, :]
    sin = jnp.sin(ang)[:, :, None, :]
    xf = x.astype(jnp.float32)
    x1, x2 = xf[..., :half], xf[..., half:]
    return jnp.concatenate([x1 * cos - x2 * sin, x1 * sin + x2 * cos], axis=-1).astype(x.dtype)


def split_columns(p):
    points = np.cumsum(np.array(SPLITS))[:-1].tolist()
    return jnp.split(p, points, axis=-1)


def mla_attention(q_nope, q_rope, k_nope, k_rope, v):
    T = q_nope.shape[1]
    scale = (MLA_NOPE_DIM + MLA_ROPE_DIM) ** -0.5
    outs = []
    for j in range(T // Q_BLOCK):
        s0, s1 = j * Q_BLOCK, (j + 1) * Q_BLOCK
        scores = (jnp.einsum('bqhd,bkhd->bhqk', q_nope[:, s0:s1], k_nope[:, :s1])
                  + jnp.einsum('bqhr,bkr->bhqk', q_rope[:, s0:s1], k_rope[:, :s1]))
        scores = scores.astype(jnp.float32) * scale
        q_chunk = (s0 + jnp.arange(Q_BLOCK)) // CHUNK
        k_chunk = jnp.arange(s1) // CHUNK
        scores = jnp.where(k_chunk[None, :] <= q_chunk[:, None], scores, -jnp.inf)
        probs = jax.nn.softmax(scores, axis=-1).astype(v.dtype)
        outs.append(jnp.einsum('bhqk,bkhd->bqhd', probs, v[:, :s1]))
    return jnp.concatenate(outs, axis=1)


def hgrn2_chunkwise(q, k, v, log_f):
    B, T, H, K = q.shape
    V = v.shape[-1]
    L = HG_BLOCK
    N = T // L

    def blocks(a):
        a = a.astype(jnp.float32)
        return a.reshape(B, N, L, H, a.shape[-1]).transpose(1, 0, 3, 2, 4)

    qb, kb, vb, gb = blocks(q), blocks(k), blocks(v), blocks(log_f)
    causal = jnp.tril(jnp.ones((L, L), dtype=bool))[:, :, None]

    def step(S, blk):
        qc, kc, vc, gc = blk
        b = jnp.cumsum(gc, axis=-2)
        diff = b[:, :, :, None, :] - b[:, :, None, :, :]
        decay = jnp.exp(jnp.where(causal, diff, -jnp.inf))
        scores = jnp.einsum('bhtk,bhsk,bhtsk->bhts', qc, kc, decay)
        o = (jnp.einsum('bhts,bhsv->bhtv', scores, vc)
             + jnp.einsum('bhtk,bhkv->bhtv', qc * jnp.exp(b), S))
        b_last = b[:, :, -1:, :]
        S_new = (jnp.exp(b_last[:, :, 0, :])[..., None] * S
                 + jnp.einsum('bhsk,bhsv->bhkv', kc * jnp.exp(b_last - b), vc))
        return S_new, o

    S0 = jnp.zeros((B, H, K, V), jnp.float32)
    _, o = lax.scan(step, S0, (qb, kb, vb, gb))
    return o.transpose(1, 0, 3, 2, 4).reshape(B, T, H, V)


def token_mixers(h, positions, w_in, q_norm_g, w_uq, kv_norm_g, w_ukv, lb,
                 hg_norm_g, w_branch_a, w_branch_b, w_out):
    B, T, _ = h.shape
    proj = h @ w_in
    c_q, c_kv, k_rope, hq, hf, hi, hgate, gate_a, gate_b = split_columns(proj)

    q = (rms_norm(c_q, q_norm_g) @ w_uq).reshape(B, T, MLA_HEADS, MLA_NOPE_DIM + MLA_ROPE_DIM)
    q_nope = q[..., :MLA_NOPE_DIM]
    q_rope = rope(q[..., MLA_NOPE_DIM:], positions)
    kv = (rms_norm(c_kv, kv_norm_g) @ w_ukv).reshape(B, T, MLA_HEADS, MLA_NOPE_DIM + MLA_V_DIM)
    k_nope, v = kv[..., :MLA_NOPE_DIM], kv[..., MLA_NOPE_DIM:]
    k_rope = rope(k_rope[:, :, None, :], positions)[:, :, 0, :]
    o_a = mla_attention(q_nope, q_rope, k_nope, k_rope, v).reshape(B, T, MLA_OUT_WIDTH)

    f = lb + (1.0 - lb) * jax.nn.sigmoid(hf.astype(jnp.float32))
    log_f = jnp.log(f).reshape(B, T, HG_HEADS, HG_K_DIM)
    k_in = (1.0 - f).reshape(B, T, HG_HEADS, HG_K_DIM)
    q_hg = jax.nn.silu(hq).reshape(B, T, HG_HEADS, HG_K_DIM)
    i_hg = hi.reshape(B, T, HG_HEADS, HG_V_DIM)
    o_hg = hgrn2_chunkwise(q_hg, k_in, i_hg, log_f)
    g_hg = jax.nn.silu(hgate.astype(jnp.float32)).reshape(B, T, HG_HEADS, HG_V_DIM)
    o_b = (rms_norm(o_hg, hg_norm_g) * g_hg).reshape(B, T, HG_WIDTH_V).astype(h.dtype)

    merged = (jax.nn.sigmoid(gate_a) * (o_a @ w_branch_a)
              + jax.nn.sigmoid(gate_b) * (o_b @ w_branch_b))
    return merged @ w_out


def swiglu(h, w_gate, w_up, w_down):
    return (jax.nn.silu(h @ w_gate) * (h @ w_up)) @ w_down


def setup_inputs(seed: int = 0) -> dict:
    key = jax.random.key(seed)
    ks = jax.random.split(key, 24)

    def normal(k, shape, scale):
        return jax.random.normal(k, shape, jnp.float32) * scale

    def gain(k, shape):
        return 1.0 + normal(k, shape, 0.02)

    x = normal(ks[0], (BATCH, SEQ, D_MODEL), 1.0)
    offsets = jax.random.randint(ks[1], (BATCH, 1), 0, 4096, dtype=jnp.int32)
    positions = offsets + jnp.arange(SEQ, dtype=jnp.int32)[None, :]
    return {
        "x": x,
        "positions": positions,
        "ln_in_g": gain(ks[2], (D_MODEL,)),
        "ln_in_b": normal(ks[3], (D_MODEL,), 0.02),
        "w_in": normal(ks[4], (DEPTH, D_MODEL, IN_WIDTH), D_MODEL ** -0.5),
        "q_norm_g": gain(ks[5], (DEPTH, MLA_Q_LORA)),
        "w_uq": normal(ks[6], (DEPTH, MLA_Q_LORA, MLA_HEADS * (MLA_NOPE_DIM + MLA_ROPE_DIM)), MLA_Q_LORA ** -0.5),
        "kv_norm_g": gain(ks[7], (DEPTH, MLA_KV_LORA)),
        "w_ukv": normal(ks[8], (DEPTH, MLA_KV_LORA, MLA_HEADS * (MLA_NOPE_DIM + MLA_V_DIM)), MLA_KV_LORA ** -0.5),
        "hg_lb": normal(ks[9], (DEPTH + 1, HG_WIDTH_K), 0.1),
        "hg_norm_g": gain(ks[10], (DEPTH, HG_V_DIM)),
        "w_branch_a": normal(ks[11], (DEPTH, MLA_OUT_WIDTH, D_MODEL), MLA_OUT_WIDTH ** -0.5),
        "w_branch_b": normal(ks[12], (DEPTH, HG_WIDTH_V, D_MODEL), HG_WIDTH_V ** -0.5),
        "w_out": normal(ks[13], (DEPTH, D_MODEL, D_MODEL), BETA * D_MODEL ** -0.5),
        "ln1_g": gain(ks[14], (DEPTH, D_MODEL)),
        "ln1_b": normal(ks[15], (DEPTH, D_MODEL), 0.02),
        "w_gate": normal(ks[16], (DEPTH, D_MODEL, D_FF), D_MODEL ** -0.5),
        "w_up": normal(ks[17], (DEPTH, D_MODEL, D_FF), D_MODEL ** -0.5),
        "w_down": normal(ks[18], (DEPTH, D_FF, D_MODEL), BETA * D_FF ** -0.5),
        "ln2_g": gain(ks[19], (DEPTH, D_MODEL)),
        "ln2_b": normal(ks[20], (DEPTH, D_MODEL), 0.02),
    }


def reference(x, positions, ln_in_g, ln_in_b, w_in, q_norm_g, w_uq, kv_norm_g, w_ukv,
              hg_lb, hg_norm_g, w_branch_a, w_branch_b, w_out, ln1_g, ln1_b,
              w_gate, w_up, w_down, ln2_g, ln2_b):
    h = layer_norm(x, ln_in_g, ln_in_b)
    lb_all = jnp.cumsum(jax.nn.softmax(hg_lb.astype(jnp.float32), axis=0), axis=0)
    for l in range(DEPTH):
        mix = token_mixers(h, positions, w_in[l], q_norm_g[l], w_uq[l], kv_norm_g[l], w_ukv[l],
                           lb_all[l], hg_norm_g[l], w_branch_a[l], w_branch_b[l], w_out[l])
        h = layer_norm(ALPHA * h + mix, ln1_g[l], ln1_b[l])
        h = layer_norm(ALPHA * h + swiglu(h, w_gate[l], w_up[l], w_down[l]), ln2_g[l], ln2_b[l])
    return h
```

```cpp
#include <hip/hip_runtime.h>
#include <cstdio>
#include <cstdint>
namespace pg8 {
#define PG8_LAS __attribute__((address_space(3)))
typedef unsigned short bf16_t;
typedef short bf16x8 __attribute__((ext_vector_type(8)));
typedef float f32x4 __attribute__((ext_vector_type(4)));
typedef unsigned u32x4 __attribute__((ext_vector_type(4)));
constexpr int BM = 256, BK = 64, HALF = 128, HTB = HALF * BK * 2  , STAGE_BYTES = 8 * HTB, NXCD = 8, WGM = 8;

__host__ __device__ __forceinline__ int lds_byte(int r, int c) { const int st = (r >> 4) * 2 + (c >> 5), rr = r & 15, cc = c & 31, ob = rr * 64 + cc * 2; return st * 1024 + (ob ^ (((ob >> 9) & 1) << 5)); }
__host__ __device__ __forceinline__ void stage_rc(int b, int& R, int& C) { const int st = b / 1024, sb = b % 1024, swz = sb ^ (((sb >> 9) & 1) << 5); R = (st >> 1) * 16 + swz / 64; C = (st & 1) * 32 + (swz % 64) / 2; }
__host__ __device__ __forceinline__ int perm32(int rho) { const int n = rho >> 4, i = rho & 15; return 8 * (i >> 2) + 4 * n + (i & 3); }

struct Unit { int pm, pn; };
struct Gemm { const bf16_t* A; const bf16_t* Bt; int M, N, K; };

struct StaticOrder {
    int nM, nN, nwg, G, c;
    __host__ __device__ void init(int M, int N, int G_, int c_) { nM = M / BM; nN = N / BM; nwg = nM * nN; G = G_; c = c_; }
    __host__ __device__ bool next(int i, Unit& u) const {
        const long L = (long)i * G + c; if (L >= nwg) return false;
        int wgid = (int)L; { const int q = nwg / NXCD, r = nwg % NXCD, xcd = wgid % NXCD, off = wgid / NXCD; wgid = (xcd < r ? xcd * (q + 1) : r * (q + 1) + (xcd - r) * q) + off; }
        const int nig = WGM * nN, gid = wgid / nig, fm = gid * WGM, gsz = (nM - fm) < WGM ? (nM - fm) : WGM;
        u.pm = fm + ((wgid % nig) % gsz); u.pn = (wgid % nig) / gsz; return true;
    }
    __device__ __forceinline__ void a_ready(const Unit&) const {}
    __device__ __forceinline__ void done(const Unit&) const {}
};

__device__ __forceinline__ unsigned cvt_pk_bf16(float lo, float hi) { unsigned r; asm volatile("v_cvt_pk_bf16_f32 %0, %1, %2" : "=v"(r) : "v"(lo), "v"(hi)); return r; }
typedef float f32x2 __attribute__((ext_vector_type(2)));
__device__ __forceinline__ f32x2 gelu_pk(f32x2 v) {
    const f32x2 av = __builtin_elementwise_abs(v), d = av * 0.2316418882f + 1.0f;
    f32x2 t; t.x = __builtin_amdgcn_rcpf(d.x); t.y = __builtin_amdgcn_rcpf(d.y);
    f32x2 q = t * 0.5307027145f + (-0.7265760135f); q = q * t + 0.7107068705f; q = q * t + (-0.142248368f); q = q * t + 0.127414796f; q = q * t;
    const f32x2 s = (v * v) * (-0.72134752044f);
    f32x2 e; e.x = __builtin_amdgcn_exp2f(s.x); e.y = __builtin_amdgcn_exp2f(s.y);
    const f32x2 m = v * (q * e), r = v - m;
    f32x2 o; o.x = v.x < 0.f ? m.x : r.x; o.y = v.y < 0.f ? m.y : r.y; return o;
}

template <class Epi, class Sched, bool ALIGN_EPI = false, bool SP2 = false>
__device__ __forceinline__ void gemm_phase(PG8_LAS unsigned char* lds, const Gemm g, const Sched& S, const Epi& E) {
    const int tid = threadIdx.x, wid = __builtin_amdgcn_readfirstlane(tid >> 6), lane = tid & 63, wr = wid >> 2, wc = wid & 3, fr = lane & 15, fq = lane >> 4;
    const int K = g.K, nt = K / BK;
    unsigned voffA[2], voffB[2];
#pragma unroll
    for (int i = 0; i < 2; ++i) { int R, C; stage_rc(tid * 16 + i * 8192, R, C); const int Rb = Epi::PERM ? ((R & ~31) + perm32(R & 31)) : R;
        voffA[i] = (unsigned)(R * K + C) * 2u; voffB[i] = (unsigned)(Rb * K + C) * 2u; }
    const size_t kstep = (size_t)(BK * 2);
    const size_t hstep = (size_t)HALF * K * 2;
    const size_t tstep = 2 * hstep;
    const unsigned ldsw = (unsigned)wid * 1024u;
    const int aoff = lds_byte(wr * 64 + fr, fq * 8), boff = lds_byte(wc * 32 + fr, fq * 8);
#define PG8_SA(b, h) (((b) * 2 + (h)) * HTB)
#define PG8_SB(b, h) ((4 + (b) * 2 + (h)) * HTB)
#define PG8_STAGE(bufoff, gbase, voff) do { _Pragma("unroll") for (int _i = 0; _i < 2; ++_i) \
        __builtin_amdgcn_global_load_lds((const unsigned*)((const char*)(gbase) + (voff)[_i]), (PG8_LAS unsigned*)(lds + (bufoff) + ldsw + _i * 8192), 16, 0, 0); } while (0)
#define PG8_LDA(dst, b, h) do { _Pragma("unroll") for (int m = 0; m < 4; ++m) _Pragma("unroll") for (int k = 0; k < 2; ++k) dst[m][k] = *(const PG8_LAS bf16x8*)(lds + PG8_SA(b, h) + aoff + m * 2048 + k * 1024); } while (0)
#define PG8_LDB(dst, b, h) do { _Pragma("unroll") for (int n = 0; n < 2; ++n) _Pragma("unroll") for (int k = 0; k < 2; ++k) dst[n][k] = *(const PG8_LAS bf16x8*)(lds + PG8_SB(b, h) + boff + n * 2048 + k * 1024); } while (0)
#define PG8_MMA(ai, bj, At, Bt) do { __builtin_amdgcn_s_setprio(1); _Pragma("unroll") for (int m = 0; m < 4; ++m) _Pragma("unroll") for (int n = 0; n < 2; ++n) _Pragma("unroll") for (int k = 0; k < 2; ++k) \
        acc[ai][bj][m][n] = __builtin_amdgcn_mfma_f32_16x16x32_bf16(Bt[n][k], At[m][k], acc[ai][bj][m][n], 0, 0, 0); __builtin_amdgcn_s_setprio(0); } while (0)
#define PG8_WAIT_V(n) asm volatile("s_waitcnt vmcnt(" #n ")" ::: "memory")
#define PG8_WAIT_L(n) asm volatile("s_waitcnt lgkmcnt(" #n ")" ::: "memory")
#define PG8_BAR __builtin_amdgcn_s_barrier()
#define PG8_SCHED __builtin_amdgcn_sched_barrier(0)
    Unit cur, nxt; int ui = 0;
    if (!S.next(0, cur)) return;
    f32x4 acc[2][2][4][2];
#pragma unroll
    for (int a = 0; a < 2; ++a)
#pragma unroll
        for (int b = 0; b < 2; ++b)
#pragma unroll
            for (int m = 0; m < 4; ++m)
#pragma unroll
                for (int n = 0; n < 2; ++n) acc[a][b][m][n] = (f32x4){0.f, 0.f, 0.f, 0.f};
    bf16x8 At[4][2], B0[2][2], B1[2][2];
    const char* cA = (const char*)g.A + (size_t)cur.pm * tstep; const char* cB = (const char*)g.Bt + (size_t)cur.pn * tstep;
    S.a_ready(cur);
    if constexpr (SP2) {
        PG8_STAGE(PG8_SB(0, 0), cB, voffB); PG8_STAGE(PG8_SB(0, 1), cB + hstep, voffB); PG8_STAGE(PG8_SA(0, 0), cA, voffA); PG8_STAGE(PG8_SA(0, 1), cA + hstep, voffA);
        if (wr == 1) PG8_BAR;
        PG8_WAIT_V(2); PG8_BAR;
        PG8_STAGE(PG8_SB(1, 0), cB + kstep, voffB); PG8_STAGE(PG8_SA(1, 0), cA + kstep, voffA); PG8_STAGE(PG8_SB(1, 1), cB + hstep + kstep, voffB);
        PG8_WAIT_V(6); PG8_BAR;
    } else {
        PG8_STAGE(PG8_SB(0, 0), cB, voffB); PG8_STAGE(PG8_SA(0, 0), cA, voffA); PG8_STAGE(PG8_SB(0, 1), cB + hstep, voffB); PG8_STAGE(PG8_SA(0, 1), cA + hstep, voffA);
        if (wr == 1) PG8_BAR;
        PG8_WAIT_V(4); PG8_BAR;
        PG8_STAGE(PG8_SB(1, 0), cB + kstep, voffB); PG8_STAGE(PG8_SA(1, 0), cA + kstep, voffA); PG8_STAGE(PG8_SB(1, 1), cB + hstep + kstep, voffB);
        PG8_WAIT_V(6); PG8_BAR;
    }
    for (;;) {
        const bool has_next = S.next(ui + 1, nxt);
        const char* nA = has_next ? (const char*)g.A + (size_t)nxt.pm * tstep : cA; const char* nB = has_next ? (const char*)g.Bt + (size_t)nxt.pn * tstep : cB;
        for (int t = 0; t < nt; t += 2) {
            const bool last = (t == nt - 2);
            const char* a1 = cA + (size_t)(t + 1) * kstep;
            const char* a2 = last ? nA : cA + (size_t)(t + 2) * kstep; const char* b2 = last ? nB : cB + (size_t)(t + 2) * kstep;
            const char* a3 = a2 + kstep; const char* b3 = b2 + kstep;
            if (last && has_next) S.a_ready(nxt);
            if constexpr (SP2) {
            PG8_LDB(B0, 0, 0); PG8_LDB(B1, 0, 1); PG8_SCHED; PG8_LDA(At, 0, 0); PG8_STAGE(PG8_SA(1, 1), a1 + hstep, voffA);
            PG8_WAIT_V(8); PG8_WAIT_L(0); PG8_BAR; PG8_MMA(0, 0, At, B0); PG8_MMA(0, 1, At, B1); PG8_BAR; PG8_SCHED;
            PG8_LDA(At, 0, 1); PG8_STAGE(PG8_SB(0, 0), b2, voffB); PG8_STAGE(PG8_SB(0, 1), b2 + hstep, voffB); PG8_STAGE(PG8_SA(0, 0), a2, voffA);
            PG8_WAIT_V(8); PG8_WAIT_L(0); PG8_BAR; PG8_MMA(1, 0, At, B0); PG8_MMA(1, 1, At, B1); PG8_BAR; PG8_SCHED;
            PG8_LDB(B0, 1, 0); PG8_LDB(B1, 1, 1); PG8_SCHED; PG8_LDA(At, 1, 0); PG8_STAGE(PG8_SA(0, 1), a2 + hstep, voffA);
            PG8_WAIT_V(8); PG8_WAIT_L(0); PG8_BAR; PG8_MMA(0, 0, At, B0); PG8_MMA(0, 1, At, B1); PG8_BAR; PG8_SCHED;
            PG8_LDA(At, 1, 1); PG8_STAGE(PG8_SB(1, 0), b3, voffB); PG8_STAGE(PG8_SB(1, 1), b3 + hstep, voffB); PG8_STAGE(PG8_SA(1, 0), a3, voffA);
            PG8_WAIT_V(8); PG8_WAIT_L(0); PG8_BAR; PG8_MMA(1, 0, At, B0); PG8_MMA(1, 1, At, B1); PG8_BAR; PG8_SCHED;
            } else {
            PG8_LDB(B0, 0, 0); PG8_SCHED; PG8_LDA(At, 0, 0); PG8_STAGE(PG8_SA(1, 1), a1 + hstep, voffA);
            PG8_WAIT_L(8); PG8_BAR; PG8_WAIT_L(0); PG8_MMA(0, 0, At, B0); PG8_BAR; PG8_SCHED;
            PG8_LDB(B1, 0, 1); PG8_STAGE(PG8_SB(0, 0), b2, voffB);
            PG8_BAR; PG8_WAIT_L(0); PG8_MMA(0, 1, At, B1); PG8_BAR;
            PG8_LDA(At, 0, 1); PG8_STAGE(PG8_SA(0, 0), a2, voffA);
            PG8_BAR; PG8_WAIT_L(0); PG8_MMA(1, 0, At, B0); PG8_BAR; PG8_SCHED;
            PG8_STAGE(PG8_SB(0, 1), b2 + hstep, voffB);
            PG8_WAIT_V(6); PG8_BAR; PG8_MMA(1, 1, At, B1); PG8_BAR;
            PG8_LDB(B0, 1, 0); PG8_SCHED; PG8_LDA(At, 1, 0); PG8_STAGE(PG8_SA(0, 1), a2 + hstep, voffA);
            PG8_WAIT_L(8); PG8_BAR; PG8_WAIT_L(0); PG8_MMA(0, 0, At, B0); PG8_BAR; PG8_SCHED;
            PG8_LDB(B1, 1, 1); PG8_STAGE(PG8_SB(1, 0), b3, voffB);
            PG8_BAR; PG8_WAIT_L(0); PG8_MMA(0, 1, At, B1); PG8_BAR;
            PG8_LDA(At, 1, 1); PG8_STAGE(PG8_SA(1, 0), a3, voffA);
            PG8_BAR; PG8_WAIT_L(0); PG8_MMA(1, 0, At, B0); PG8_BAR; PG8_SCHED;
            PG8_STAGE(PG8_SB(1, 1), b3 + hstep, voffB);
            PG8_WAIT_V(6); PG8_BAR; PG8_MMA(1, 1, At, B1); PG8_BAR;
            }
        }
        if constexpr (ALIGN_EPI) { if (wr == 0) PG8_BAR; }
        if constexpr (!Epi::AFTER_DRAIN) { E(acc, cur, wr, wc, fr, fq); S.done(cur); }
        if (!has_next) break;
        if (!E.keep(cur)) {
#pragma unroll
        for (int a = 0; a < 2; ++a)
#pragma unroll
            for (int b = 0; b < 2; ++b)
#pragma unroll
                for (int m = 0; m < 4; ++m)
#pragma unroll
                    for (int n = 0; n < 2; ++n) acc[a][b][m][n] = (f32x4){0.f, 0.f, 0.f, 0.f};
        }
        cur = nxt; cA = nA; cB = nB; ++ui;
        if constexpr (ALIGN_EPI) { if (wr == 1) PG8_BAR; }
    }
    PG8_WAIT_V(0);
    if constexpr (!ALIGN_EPI) { if (wr == 0) PG8_BAR; }
    PG8_BAR;
    if constexpr (Epi::AFTER_DRAIN) { E.fused(acc, cur, wr, wc, fr, fq, lds, wid, lane); S.done(cur); }
#undef PG8_SA
#undef PG8_SB
#undef PG8_STAGE
#undef PG8_LDA
#undef PG8_LDB
#undef PG8_MMA
#undef PG8_WAIT_V
#undef PG8_WAIT_L
#undef PG8_BAR
#undef PG8_SCHED
}
}

namespace pg8 {
__device__ __forceinline__ float bf2f(unsigned short h) { return __uint_as_float(((unsigned)h) << 16); }
__device__ __forceinline__ float bflo(unsigned w) { return __uint_as_float(w << 16); }
__device__ __forceinline__ float bfhi(unsigned w) { return __uint_as_float(w & 0xffff0000u); }
__device__ __forceinline__ float sigm(float x) { return __builtin_amdgcn_rcpf(1.f + __builtin_amdgcn_exp2f(-1.4426950408889634f * x)); }
__device__ __forceinline__ u32x4 pack8(f32x4 a, f32x4 b) { u32x4 w; w.x = cvt_pk_bf16(a[0], a[1]); w.y = cvt_pk_bf16(a[2], a[3]); w.z = cvt_pk_bf16(b[0], b[1]); w.w = cvt_pk_bf16(b[2], b[3]); return w; }

struct EpiProj {
    static constexpr bool PERM = true, AFTER_DRAIN = false;
    float* CF; bf16_t* QH; float* G; bf16_t* HI; bf16_t* GS; bf16_t* GA; bf16_t* GB; const float* hg_lb;
    __device__ __forceinline__ bool keep(const Unit&) const { return false; }
    __device__ __forceinline__ void operator()(f32x4 (&acc)[2][2][4][2], const Unit& u, int wr, int wc, int fr, int fq) const {
        const int pn = u.pn; int mode, ct, ldc; float* pf = nullptr; bf16_t* ph = nullptr;
        if (pn < 7) { mode = 0; ct = pn; ldc = 1792; pf = CF; }
        else if (pn < 15) { mode = 1; ct = pn - 7; ldc = 2048; ph = QH; }
        else if (pn < 23) { mode = 2; ct = pn - 15; ldc = 2048; pf = G; }
        else if (pn < 31) { mode = 3; ct = pn - 23; ldc = 2048; ph = HI; }
        else if (pn < 39) { mode = 1; ct = pn - 31; ldc = 2048; ph = GS; }
        else if (pn < 55) { mode = 4; ct = pn - 39; ldc = 4096; ph = GA; }
        else { mode = 4; ct = pn - 55; ldc = 4096; ph = GB; }
        const int row0 = u.pm * BM + wr * 64 + fr, col0 = ct * BM + wc * 32 + 8 * fq;
        if (mode == 0) {
#pragma unroll
            for (int ai = 0; ai < 2; ++ai)
#pragma unroll
                for (int m = 0; m < 4; ++m) { float* rowp = pf + (size_t)(row0 + ai * HALF + m * 16) * ldc + col0;
#pragma unroll
                    for (int bj = 0; bj < 2; ++bj) { *(f32x4*)(rowp + bj * HALF) = acc[ai][bj][m][0]; *(f32x4*)(rowp + bj * HALF + 4) = acc[ai][bj][m][1]; } }
        } else if (mode == 2) {
#pragma unroll
            for (int bj = 0; bj < 2; ++bj) {
                f32x4 lb[2];
#pragma unroll
                for (int n = 0; n < 2; ++n) { const f32x4 l0 = *(const f32x4*)(hg_lb + col0 + bj * HALF + 4 * n), l1 = *(const f32x4*)(hg_lb + 2048 + col0 + bj * HALF + 4 * n);
#pragma unroll
                    for (int i = 0; i < 4; ++i) lb[n][i] = sigm(l0[i] - l1[i]); }
#pragma unroll
                for (int ai = 0; ai < 2; ++ai)
#pragma unroll
                    for (int m = 0; m < 4; ++m) { float* rowp = pf + (size_t)(row0 + ai * HALF + m * 16) * ldc + col0 + bj * HALF;
#pragma unroll
                        for (int n = 0; n < 2; ++n) { f32x4 v = acc[ai][bj][m][n], o;
#pragma unroll
                            for (int i = 0; i < 4; ++i) { const float f = lb[n][i] + (1.f - lb[n][i]) * sigm(v[i]); o[i] = __builtin_amdgcn_logf(f) * 0.6931471805599453f; }
                            *(f32x4*)(rowp + 4 * n) = o; } }
            }
        } else {
#pragma unroll
            for (int ai = 0; ai < 2; ++ai)
#pragma unroll
                for (int m = 0; m < 4; ++m) { bf16_t* rowp = ph + (size_t)(row0 + ai * HALF + m * 16) * ldc + col0;
#pragma unroll
                    for (int bj = 0; bj < 2; ++bj) { f32x4 v0 = acc[ai][bj][m][0], v1 = acc[ai][bj][m][1];
                        if (mode == 1) {
#pragma unroll
                            for (int i = 0; i < 4; ++i) { v0[i] = v0[i] * sigm(v0[i]); v1[i] = v1[i] * sigm(v1[i]); } }
                        else if (mode == 4) {
#pragma unroll
                            for (int i = 0; i < 4; ++i) { v0[i] = sigm(v0[i]); v1[i] = sigm(v1[i]); } }
                        *(u32x4*)(rowp + bj * HALF) = pack8(v0, v1); } }
        }
    }
};
struct EpiPlain {
    static constexpr bool PERM = true, AFTER_DRAIN = false;
    bf16_t* O; int ldc;
    __device__ __forceinline__ bool keep(const Unit&) const { return false; }
    __device__ __forceinline__ void operator()(f32x4 (&acc)[2][2][4][2], const Unit& u, int wr, int wc, int fr, int fq) const {
        const int row0 = u.pm * BM + wr * 64 + fr, col0 = u.pn * BM + wc * 32 + 8 * fq;
#pragma unroll
        for (int ai = 0; ai < 2; ++ai)
#pragma unroll
            for (int m = 0; m < 4; ++m) { bf16_t* rowp = O + (size_t)(row0 + ai * HALF + m * 16) * ldc + col0;
#pragma unroll
                for (int bj = 0; bj < 2; ++bj) *(u32x4*)(rowp + bj * HALF) = pack8(acc[ai][bj][m][0], acc[ai][bj][m][1]); }
    }
};
struct EpiQ {
    static constexpr bool PERM = true, AFTER_DRAIN = false;
    bf16_t* Q; const float* CS;
    __device__ __forceinline__ bool keep(const Unit&) const { return false; }
    __device__ __forceinline__ void operator()(f32x4 (&acc)[2][2][4][2], const Unit& u, int wr, int wc, int fr, int fq) const {
        const int row0 = u.pm * BM + wr * 64 + fr;
#pragma unroll
        for (int bj = 0; bj < 2; ++bj) {
            const int gi = u.pn * 8 + bj * 4 + wc, part = gi % 6, col0 = gi * 32 + 8 * fq;
            if (part < 4) {
#pragma unroll
                for (int ai = 0; ai < 2; ++ai)
#pragma unroll
                    for (int m = 0; m < 4; ++m) *(u32x4*)(Q + (size_t)(row0 + ai * HALF + m * 16) * 3072 + col0) = pack8(acc[ai][bj][m][0], acc[ai][bj][m][1]);
            } else {
                const int i0 = (part - 4) * 16 + 4 * fq;
#pragma unroll
                for (int ai = 0; ai < 2; ++ai)
#pragma unroll
                    for (int m = 0; m < 4; ++m) { const int row = row0 + ai * HALF + m * 16;
                        const f32x4 c = *(const f32x4*)(CS + (size_t)row * 64 + i0), s = *(const f32x4*)(CS + (size_t)row * 64 + 32 + i0);
                        const f32x4 v0 = acc[ai][bj][m][0], v1 = acc[ai][bj][m][1]; f32x4 o0, o1;
                        o0[0] = v0[0] * c[0] - v0[1] * s[0]; o0[1] = v0[0] * s[0] + v0[1] * c[0]; o0[2] = v0[2] * c[1] - v0[3] * s[1]; o0[3] = v0[2] * s[1] + v0[3] * c[1];
                        o1[0] = v1[0] * c[2] - v1[1] * s[2]; o1[1] = v1[0] * s[2] + v1[1] * c[2]; o1[2] = v1[2] * c[3] - v1[3] * s[3]; o1[3] = v1[2] * s[3] + v1[3] * c[3];
                        *(u32x4*)(Q + (size_t)row * 3072 + col0) = pack8(o0, o1); }
            }
        }
    }
};
struct EpiMerge {
    static constexpr bool PERM = true, AFTER_DRAIN = false;
    const bf16_t* GA; const bf16_t* GB; bf16_t* O;
    __device__ __forceinline__ bool keep(const Unit& u) const { return u.pm < 32; }
    __device__ __forceinline__ void operator()(f32x4 (&acc)[2][2][4][2], const Unit& u, int wr, int wc, int fr, int fq) const {
        const bool second = u.pm >= 32;
        const int row0 = (u.pm & 31) * BM + wr * 64 + fr, col0 = (u.pn & 15) * BM + wc * 32 + 8 * fq;
#pragma unroll
        for (int ai = 0; ai < 2; ++ai)
#pragma unroll
            for (int m = 0; m < 4; ++m) { const size_t off = (size_t)(row0 + ai * HALF + m * 16) * 4096 + col0;
#pragma unroll
                for (int bj = 0; bj < 2; ++bj) {
                    const u32x4 gb = *(const u32x4*)(GB + off + bj * HALF);
                    f32x4 b0, b1; b0[0] = bflo(gb.x); b0[1] = bfhi(gb.x); b0[2] = bflo(gb.y); b0[3] = bfhi(gb.y); b1[0] = bflo(gb.z); b1[1] = bfhi(gb.z); b1[2] = bflo(gb.w); b1[3] = bfhi(gb.w);
#pragma unroll
                    for (int i = 0; i < 4; ++i) { b0[i] = fmaxf(b0[i], 1e-30f); b1[i] = fmaxf(b1[i], 1e-30f); }
                    if (!second) {
                        const u32x4 ga = *(const u32x4*)(GA + off + bj * HALF);
                        f32x4 a0, a1; a0[0] = bflo(ga.x); a0[1] = bfhi(ga.x); a0[2] = bflo(ga.y); a0[3] = bfhi(ga.y); a1[0] = bflo(ga.z); a1[1] = bfhi(ga.z); a1[2] = bflo(ga.w); a1[3] = bfhi(ga.w);
#pragma unroll
                        for (int i = 0; i < 4; ++i) { acc[ai][bj][m][0][i] *= a0[i] * __builtin_amdgcn_rcpf(b0[i]); acc[ai][bj][m][1][i] *= a1[i] * __builtin_amdgcn_rcpf(b1[i]); }
                    } else {
                        *(u32x4*)(O + off + bj * HALF) = pack8(acc[ai][bj][m][0] * b0, acc[ai][bj][m][1] * b1);
                    }
                } }
    }
};
struct DualOrder {
    StaticOrder S;
    __device__ __forceinline__ bool next(int i, Unit& u) const { if (!S.next(i >> 1, u)) return false; if (i & 1) { u.pm += 32; u.pn += 16; } return true; }
    __device__ __forceinline__ void a_ready(const Unit&) const {}
    __device__ __forceinline__ void done(const Unit&) const {}
};
struct EpiMix {
    static constexpr bool PERM = false, AFTER_DRAIN = false;
    const float* X; const float* ST; const float* g; const float* b; float* Y; float alpha;
    __device__ __forceinline__ bool keep(const Unit&) const { return false; }
    __device__ __forceinline__ void operator()(f32x4 (&acc)[2][2][4][2], const Unit& u, int wr, int wc, int fr, int fq) const {
        const int row0 = u.pm * BM + wr * 64 + fr, col0 = u.pn * BM + wc * 32 + 4 * fq;
#pragma unroll
        for (int ai = 0; ai < 2; ++ai)
#pragma unroll
            for (int m = 0; m < 4; ++m) { const int row = row0 + ai * HALF + m * 16; const float mu = ST[2 * row], rs = ST[2 * row + 1]; const size_t off = (size_t)row * 4096 + col0;
#pragma unroll
                for (int bj = 0; bj < 2; ++bj)
#pragma unroll
                    for (int n = 0; n < 2; ++n) { const int cc = bj * HALF + n * 16; const f32x4 xv = *(const f32x4*)(X + off + cc), gv = *(const f32x4*)(g + col0 + cc), bv = *(const f32x4*)(b + col0 + cc);
                        *(f32x4*)(Y + off + cc) = ((xv - mu) * rs * gv + bv) * alpha + acc[ai][bj][m][n]; } }
    }
};
struct EpiSwiglu {
    static constexpr bool PERM = true, AFTER_DRAIN = false;
    bf16_t* O;
    __device__ __forceinline__ bool keep(const Unit&) const { return false; }
    __device__ __forceinline__ void operator()(f32x4 (&acc)[2][2][4][2], const Unit& u, int wr, int wc, int fr, int fq) const {
        const int row0 = u.pm * BM + wr * 64 + fr, col0 = u.pn * HALF + wc * 32 + 8 * fq;
#pragma unroll
        for (int ai = 0; ai < 2; ++ai)
#pragma unroll
            for (int m = 0; m < 4; ++m) { f32x4 o0, o1;
#pragma unroll
                for (int i = 0; i < 4; ++i) { const float g0 = acc[ai][0][m][0][i], g1 = acc[ai][0][m][1][i]; o0[i] = g0 * sigm(g0) * acc[ai][1][m][0][i]; o1[i] = g1 * sigm(g1) * acc[ai][1][m][1][i]; }
                *(u32x4*)(O + (size_t)(row0 + ai * HALF + m * 16) * 11008 + col0) = pack8(o0, o1); }
    }
};
struct EpiDown {
    static constexpr bool PERM = false, AFTER_DRAIN = false;
    const float* H1; float* Z; float alpha;
    __device__ __forceinline__ bool keep(const Unit&) const { return false; }
    __device__ __forceinline__ void operator()(f32x4 (&acc)[2][2][4][2], const Unit& u, int wr, int wc, int fr, int fq) const {
        const int row0 = u.pm * BM + wr * 64 + fr, col0 = u.pn * BM + wc * 32 + 4 * fq;
#pragma unroll
        for (int ai = 0; ai < 2; ++ai)
#pragma unroll
            for (int m = 0; m < 4; ++m) { const size_t off = (size_t)(row0 + ai * HALF + m * 16) * 4096 + col0;
#pragma unroll
                for (int bj = 0; bj < 2; ++bj)
#pragma unroll
                    for (int n = 0; n < 2; ++n) { const int cc = bj * HALF + n * 16; *(f32x4*)(Z + off + cc) = *(const f32x4*)(H1 + off + cc) * alpha + acc[ai][bj][m][n]; } }
    }
};
}

#ifndef MK_ONE_LAUNCH
#define MK_ONE_LAUNCH 0
#endif
constexpr int NWAVES = 8;
constexpr int NPHASE = 11;
constexpr int MTOK = 8192, DM = 4096, DFF = 11008, NPROJ = 18176;
constexpr float LN_EPS = 1e-5f;
constexpr float ALPHA = 1.189207115002721f;
constexpr float QSCALE = 0.07216878364870322f * 1.4426950408889634f;
constexpr size_t MiB = 1u << 20;
constexpr size_t WS_CTL = 0, CTL_ZERO_BYTES = 1 * MiB;
constexpr size_t WS_CS = 1 * MiB;
constexpr size_t WS_ST = 3 * MiB;
constexpr size_t WS_WIN = 8 * MiB;
constexpr size_t WS_Q = 8 * MiB;
constexpr size_t WS_KV = 56 * MiB;
constexpr size_t WS_CQN = 120 * MiB;
constexpr size_t WS_CKVN = 136 * MiB;
constexpr size_t WS_KROPE = 144 * MiB;
constexpr size_t WS_WUQ = 150 * MiB, WS_WUKV = 156 * MiB, WS_WAB = 160 * MiB, WS_WOUT = 192 * MiB, WS_WGU = 224 * MiB, WS_WDOWN = 396 * MiB;
constexpr size_t WS_HB = 482 * MiB;
constexpr size_t WS_CF = 546 * MiB;
constexpr size_t WS_QH = 602 * MiB, WS_G = 634 * MiB, WS_HI = 698 * MiB, WS_GS = 730 * MiB, WS_GA = 762 * MiB, WS_GB = 826 * MiB;
constexpr size_t WS_R = 546 * MiB;
constexpr size_t WS_ACT = 674 * MiB;
constexpr size_t WS_OAB = 890 * MiB;
constexpr size_t WS_END = 954 * MiB;
static_assert(WS_WIN + (size_t)NPROJ * DM * 2 <= WS_WUQ && WS_KROPE + (size_t)MTOK * 64 * 2 <= WS_WUQ, "ws map 1");
static_assert(WS_WGU + (size_t)2 * DFF * DM * 2 <= WS_WDOWN && WS_WDOWN + (size_t)DFF * DM * 2 <= WS_HB, "ws map 2");
static_assert(WS_CF + (size_t)MTOK * 1792 * 4 <= WS_QH && WS_R + (size_t)MTOK * DM * 4 <= WS_ACT && WS_ACT + (size_t)MTOK * DFF * 2 <= WS_OAB, "ws map 3");
constexpr int CW_BAR = 4096;
constexpr int RING_OFF = 0, RING_BYTES = 131072;
constexpr int LDSCTL_OFF = RING_BYTES, MISC_OFF = LDSCTL_OFF + 320;
constexpr int LDS_BYTES = 147456;
#define GAS __attribute__((address_space(1)))
#define LAS __attribute__((address_space(3)))
typedef unsigned short bf16;
typedef unsigned v4u __attribute__((ext_vector_type(4)));
typedef float f32x4 __attribute__((ext_vector_type(4)));
typedef short bf16x8 __attribute__((ext_vector_type(8)));
typedef GAS unsigned gu32;
typedef GAS unsigned long long gu64;
#define RLX_AGENT __ATOMIC_RELAXED, __HIP_MEMORY_SCOPE_AGENT
#define LDS_WAIT() asm volatile("s_waitcnt lgkmcnt(0)" ::: "memory")
#define VM_WAIT() asm volatile("s_waitcnt vmcnt(0)" ::: "memory")
__device__ __forceinline__ unsigned long long rt() { return __builtin_amdgcn_s_memrealtime(); }
__device__ __forceinline__ unsigned f2bf(float f) { unsigned u = __builtin_bit_cast(unsigned, f); return (u + 0x7fffu + ((u >> 16) & 1u)) >> 16; }
__device__ __forceinline__ unsigned pk2(float lo, float hi) { return f2bf(lo) | (f2bf(hi) << 16); }

#define XB_TMO      128
#define XB_XCNT(j)  (256  + 64 * (j))
#define XB_XSUB(j)  (1280 + 64 * (j))
#define XB_XGEN(j)  (2304 + 64 * (j))
#define XB_TOP      3328
#define XB_TOPGEN   3392
#define XCD_BAR_WORDS 3456
#define XB_SPIN_CAP (1u << 18)

__device__ __forceinline__ unsigned xb_ld(unsigned* p)              { return __hip_atomic_load(p, __ATOMIC_RELAXED, __HIP_MEMORY_SCOPE_AGENT); }
__device__ __forceinline__ unsigned xb_add(unsigned* p, unsigned v) { return __hip_atomic_fetch_add(p, v, __ATOMIC_RELAXED, __HIP_MEMORY_SCOPE_AGENT); }
__device__ __forceinline__ unsigned xb_xcc_id() { return (unsigned)__builtin_amdgcn_s_getreg((3 << 11) | 20) & 0xFu; }
#define XB_SPIN(cond, bar) do { unsigned _sp = 0; while (cond) { __builtin_amdgcn_s_sleep(1); \
    if ((++_sp & 255u) == 0u) { if (xb_ld(&(bar)[XB_TMO])) break; if (_sp > XB_SPIN_CAP) { atomicAdd(&(bar)[XB_TMO], 1u); break; } } } } while (0)

struct XcdBarrier {
    unsigned* bar; unsigned x;
    volatile LAS unsigned* st;
};

__device__ __forceinline__ XcdBarrier xcd_barrier_post(unsigned* bar, volatile LAS unsigned* st) {
    XcdBarrier b; b.bar = bar; b.x = xb_xcc_id(); b.st = st;
    if (threadIdx.x == 0) (void)xb_add(&bar[XB_XCNT(b.x)], 1u);
    return b;
}
__device__ __forceinline__ void xcd_barrier_complete(unsigned* bar, unsigned x, unsigned& nloc, unsigned& nx) {
    const unsigned G = gridDim.x * gridDim.y * gridDim.z;
    unsigned sum, cnt, mine, sp = 0u;
    for (;;) {
        sum = 0u; cnt = 0u; mine = 0u;
#pragma unroll
        for (unsigned j = 0; j < 16; ++j) { const unsigned c = xb_ld(&bar[XB_XCNT(j)]); sum += c; cnt += (c > 0u) ? 1u : 0u; mine = (j == x) ? c : mine; }
        if (sum == G) break;
        __builtin_amdgcn_s_sleep(1);
        if ((++sp & 255u) == 0u) { if (xb_ld(&bar[XB_TMO])) break; if (sp > XB_SPIN_CAP) { atomicAdd(&bar[XB_TMO], 1u); break; } }
    }
    nloc = mine > 0u ? mine : 1u; nx = cnt > 0u ? cnt : 1u;
}

__device__ __forceinline__ void xcd_barrier(const XcdBarrier& b) {
    asm volatile("s_waitcnt vmcnt(0)" ::: "memory");
    __syncthreads();
    if (threadIdx.x == 0) {
        unsigned* bar = b.bar;
        __builtin_amdgcn_s_waitcnt(0);
        unsigned nloc = b.st[0], nx = b.st[1];
        if (nloc == 0u) { xcd_barrier_complete(bar, b.x, nloc, nx); b.st[0] = nloc; b.st[1] = nx; }
        const unsigned old = xb_add(&bar[XB_XSUB(b.x)], 1u);
        const unsigned gen = old / nloc;
        if (old + 1u == (gen + 1u) * nloc) {
            __builtin_amdgcn_fence(__ATOMIC_RELEASE, "agent");
            asm volatile("s_waitcnt vmcnt(0)" ::: "memory");
            const unsigned og = xb_add(&bar[XB_TOP], 1u);
            const unsigned tg = og / nx;
            if (og + 1u == (tg + 1u) * nx) xb_add(&bar[XB_TOPGEN], 1u);
            else XB_SPIN(xb_ld(&bar[XB_TOPGEN]) == tg, bar);
            __builtin_amdgcn_fence(__ATOMIC_ACQUIRE, "agent");
            xb_add(&bar[XB_XGEN(b.x)], 1u);
            asm volatile("s_waitcnt vmcnt(0)" ::: "memory");
        } else {
            XB_SPIN(xb_ld(&bar[XB_XGEN(b.x)]) == gen, bar);
            __builtin_amdgcn_fence(__ATOMIC_ACQUIRE, "agent");
            asm volatile("s_waitcnt vmcnt(0)" ::: "memory");
        }
    }
    __syncthreads();
}

struct Frame {
    LAS unsigned char* lds;
    volatile LAS unsigned* MISC;
    gu32* ctl;
    int tid, lane, wave, vcu, G;
};
__device__ __forceinline__ float wave_sum(float v) {
#pragma unroll
    for (int o = 1; o < 64; o <<= 1) v += __shfl_xor(v, o);
    return v;
}
__device__ __forceinline__ float bf2f(bf16 h) { return __uint_as_float(((unsigned)h) << 16); }
__device__ __forceinline__ float bflo(unsigned w) { return __uint_as_float(w << 16); }
__device__ __forceinline__ float bfhi(unsigned w) { return __uint_as_float(w & 0xffff0000u); }

template <class RowMap>
__device__ __forceinline__ void p0_transpose_item(const float* W, int K, int N, bf16* WT, const RowMap rm, float scale, LAS float* scr, int item, int lane) {
    const int nblk = N / 32, kb = item / nblk, nb = item % nblk, k0 = 64 * kb, n0 = 32 * nb;
#pragma unroll 8
    for (int i = 0; i < 32; ++i) { const int kk = 2 * i + (lane >> 5); scr[kk * 33 + (lane & 31)] = W[(size_t)(k0 + kk) * N + n0 + (lane & 31)]; }
    LDS_WAIT(); asm volatile("" ::: "memory");
    const int c = lane & 7;
#pragma unroll
    for (int j = 0; j < 4; ++j) { const int n = (lane >> 3) + 8 * j; const LAS float* s = scr + (8 * c) * 33 + n;
        v4u o; o.x = pk2(s[0 * 33] * scale, s[1 * 33] * scale); o.y = pk2(s[2 * 33] * scale, s[3 * 33] * scale); o.z = pk2(s[4 * 33] * scale, s[5 * 33] * scale); o.w = pk2(s[6 * 33] * scale, s[7 * 33] * scale);
        *(GAS v4u*)(WT + (size_t)rm(n0 + n) * K + k0 + 8 * c) = o; }
    LDS_WAIT(); asm volatile("" ::: "memory");
}
struct RmId { int off; __device__ __forceinline__ int operator()(int n) const { return n + off; } };
struct RmWin { __device__ __forceinline__ int operator()(int n) const { if (n < 1536) return n; if (n < 1600) { const int i = n - 1536; return 1536 + ((i & 31) << 1) + (i >> 5); } return n + 192; } };
struct RmUq { __device__ __forceinline__ int operator()(int n) const { const int hd = n / 192, w = n - hd * 192; if (w < 128) return n; const int i = w - 128; return hd * 192 + 128 + ((i & 31) << 1) + (i >> 5); } };
struct RmGu { int up; __device__ __forceinline__ int operator()(int n) const { return ((n >> 7) << 8) + (n & 127) + up; } };

template <bool WF32, bool WBF, bool WST>
__device__ __forceinline__ void ln_row(const float* xrow, const float* g, const float* b, float* of, bf16* ob, float* st, int lane) {
    const GAS f32x4* xr = (const GAS f32x4*)xrow + lane;
    f32x4 v[16]; float s = 0.f;
#pragma unroll
    for (int j = 0; j < 16; ++j) { v[j] = xr[64 * j]; s += (v[j].x + v[j].y) + (v[j].z + v[j].w); }
    const float mean = wave_sum(s) * (1.f / 4096.f); float s2 = 0.f;
#pragma unroll
    for (int j = 0; j < 16; ++j) { v[j] = v[j] - mean; s2 += (v[j].x * v[j].x + v[j].y * v[j].y) + (v[j].z * v[j].z + v[j].w * v[j].w); }
    const float rstd = 1.f / sqrtf(wave_sum(s2) * (1.f / 4096.f) + LN_EPS);
    if (WST) { if (lane == 0) { st[0] = mean; st[1] = rstd; } }
    const GAS f32x4* gr = (const GAS f32x4*)g + lane; const GAS f32x4* br = (const GAS f32x4*)b + lane;
#pragma unroll
    for (int j = 0; j < 16; ++j) { const f32x4 o = v[j] * rstd * gr[64 * j] + br[64 * j];
        if (WF32) ((GAS f32x4*)of)[lane + 64 * j] = o;
        if (WBF) ((GAS unsigned long long*)ob)[lane + 64 * j] = (unsigned long long)pk2(o.x, o.y) | ((unsigned long long)pk2(o.z, o.w) << 32); }
}

struct Args { const void* in[21]; float* out; unsigned char* ws; int ph_lo, ph_hi; };
__global__ void __launch_bounds__(NWAVES * 64, 2) mega_fwd(Args args) {
    extern __shared__ __attribute__((aligned(16))) unsigned char lds[];
    Frame F;
    F.lds = (LAS unsigned char*)lds;
    F.MISC = (volatile LAS unsigned*)(F.lds + MISC_OFF);
    F.tid = threadIdx.x; F.lane = F.tid & 63; F.wave = __builtin_amdgcn_readfirstlane(F.tid >> 6);
    F.G = gridDim.x; { const int bx = blockIdx.x; F.vcu = (F.G % 8 == 0) ? (bx % 8) * (F.G / 8) + bx / 8 : bx; }
    unsigned char* ws = args.ws;
    F.ctl = (gu32*)(ws + WS_CTL);
    const float* x = (const float*)args.in[0]; const int* positions = (const int*)args.in[1];
    const float* ln_in_g = (const float*)args.in[2]; const float* ln_in_b = (const float*)args.in[3];
    const float* w_in = (const float*)args.in[4]; const float* q_norm_g = (const float*)args.in[5]; const float* w_uq = (const float*)args.in[6];
    const float* kv_norm_g = (const float*)args.in[7]; const float* w_ukv = (const float*)args.in[8]; const float* hg_lb = (const float*)args.in[9];
    const float* hg_norm_g = (const float*)args.in[10]; const float* w_a = (const float*)args.in[11]; const float* w_b = (const float*)args.in[12];
    const float* w_out = (const float*)args.in[13]; const float* ln1_g = (const float*)args.in[14]; const float* ln1_b = (const float*)args.in[15];
    const float* w_gate = (const float*)args.in[16]; const float* w_up = (const float*)args.in[17]; const float* w_down = (const float*)args.in[18];
    const float* ln2_g = (const float*)args.in[19]; const float* ln2_b = (const float*)args.in[20];
    float* out = args.out;
    bf16* Wt_in = (bf16*)(ws + WS_WIN); bf16* Wt_uq = (bf16*)(ws + WS_WUQ); bf16* Wt_ukv = (bf16*)(ws + WS_WUKV); bf16* Wt_ab = (bf16*)(ws + WS_WAB);
    bf16* Wt_out = (bf16*)(ws + WS_WOUT); bf16* Wt_gu = (bf16*)(ws + WS_WGU); bf16* Wt_down = (bf16*)(ws + WS_WDOWN);
    bf16* HB = (bf16*)(ws + WS_HB); float* CS = (float*)(ws + WS_CS); float* ST = (float*)(ws + WS_ST);
    float* CF = (float*)(ws + WS_CF); bf16* QH = (bf16*)(ws + WS_QH); float* GL = (float*)(ws + WS_G); bf16* HI = (bf16*)(ws + WS_HI); bf16* GS = (bf16*)(ws + WS_GS);
    bf16* GA = (bf16*)(ws + WS_GA); bf16* GB = (bf16*)(ws + WS_GB);
    bf16* Q = (bf16*)(ws + WS_Q); bf16* KV = (bf16*)(ws + WS_KV); bf16* CQN = (bf16*)(ws + WS_CQN); bf16* CKVN = (bf16*)(ws + WS_CKVN); bf16* KROPE = (bf16*)(ws + WS_KROPE);
    bf16* OAB = (bf16*)(ws + WS_OAB); bf16* MERGED = (bf16*)(ws + WS_KV); float* R = (float*)(ws + WS_R); bf16* ACT = (bf16*)(ws + WS_ACT);

    for (int u = F.tid; u < (LDS_BYTES - LDSCTL_OFF) / 4; u += NWAVES * 64) ((LAS unsigned*)(F.lds + LDSCTL_OFF))[u] = 0u;
    __syncthreads();
#if MK_ONE_LAUNCH
    XcdBarrier bar = xcd_barrier_post((unsigned*)(F.ctl + CW_BAR), F.MISC + 8);
#define GRID_BAR() xcd_barrier(bar)
#else
#define GRID_BAR() do {} while (0)
#endif
    const int lo = args.ph_lo, hi = args.ph_hi;
#define IN(k) (lo <= (k) && (k) < hi)
#define BOTH(k) (IN(k) && IN((k) + 1))
    const int gw = F.vcu * NWAVES + F.wave, NGW = F.G * NWAVES;
    const int gt = blockIdx.x * (NWAVES * 64) + F.tid, NGT = F.G * NWAVES * 64;

    if (IN(0)) {
        LAS float* scr = (LAS float*)(F.lds + RING_OFF + F.wave * 16384);
        constexpr int I_IN = (DM / 64) * (17984 / 32), I_UQ = (1024 / 64) * (3072 / 32), I_UKV = (512 / 64) * (4096 / 32), I_A = (2048 / 64) * (4096 / 32), I_B = I_A,
                      I_OUT = (4096 / 64) * (4096 / 32), I_G = (4096 / 64) * (DFF / 32), I_U = I_G, I_D = (DFF / 64) * (4096 / 32);
        constexpr int NITEMS = I_IN + I_UQ + I_UKV + I_A + I_B + I_OUT + I_G + I_U + I_D;
        for (int it = gw; it < NITEMS; it += NGW) {
            int r = it;
            if (r < I_IN) { p0_transpose_item(w_in, DM, 17984, Wt_in, RmWin{}, 1.f, scr, r, F.lane); continue; } r -= I_IN;
            if (r < I_UQ) { p0_transpose_item(w_uq, 1024, 3072, Wt_uq, RmUq{}, QSCALE, scr, r, F.lane); continue; } r -= I_UQ;
            if (r < I_UKV) { p0_transpose_item(w_ukv, 512, 4096, Wt_ukv, RmId{0}, 1.f, scr, r, F.lane); continue; } r -= I_UKV;
            if (r < I_A) { p0_transpose_item(w_a, 2048, 4096, Wt_ab, RmId{0}, 1.f, scr, r, F.lane); continue; } r -= I_A;
            if (r < I_B) { p0_transpose_item(w_b, 2048, 4096, Wt_ab, RmId{4096}, 1.f, scr, r, F.lane); continue; } r -= I_B;
            if (r < I_OUT) { p0_transpose_item(w_out, 4096, 4096, Wt_out, RmId{0}, 1.f, scr, r, F.lane); continue; } r -= I_OUT;
            if (r < I_G) { p0_transpose_item(w_gate, 4096, DFF, Wt_gu, RmGu{0}, 1.f, scr, r, F.lane); continue; } r -= I_G;
            if (r < I_U) { p0_transpose_item(w_up, 4096, DFF, Wt_gu, RmGu{128}, 1.f, scr, r, F.lane); continue; } r -= I_U;
            p0_transpose_item(w_down, DFF, 4096, Wt_down, RmId{0}, 1.f, scr, r, F.lane);
        }
        for (int i = gt; i < 192 * DM / 8; i += NGT) ((GAS v4u*)(Wt_in + (size_t)1600 * DM))[i] = (v4u){0u, 0u, 0u, 0u};
        for (int m = gw; m < MTOK; m += NGW) ln_row<false, true, true>(x + (size_t)m * DM, ln_in_g, ln_in_b, nullptr, HB + (size_t)m * DM, ST + 2 * m, F.lane);
        for (int i = gt; i < MTOK * 32; i += NGT) { const int row = i >> 5, k = i & 31;
            const float inv = exp2f(-(float)k * (13.287712379549449f / 32.f)); const float ang = (float)positions[row] * inv;
            CS[(size_t)row * 64 + k] = cosf(ang); CS[(size_t)row * 64 + 32 + k] = sinf(ang); }
        if (BOTH(0)) GRID_BAR();
    }
    if (IN(1)) {
        pg8::Gemm g{HB, Wt_in, MTOK, NPROJ, DM}; pg8::StaticOrder S; S.init(MTOK, NPROJ, F.G, (int)blockIdx.x);
        pg8::EpiProj E{CF, QH, GL, HI, GS, GA, GB, hg_lb};
        pg8::gemm_phase<pg8::EpiProj, pg8::StaticOrder, true, true>(F.lds + RING_OFF, g, S, E);
        if (BOTH(1)) GRID_BAR();
    }
    if (IN(2)) {
        for (int m = gw; m < MTOK; m += NGW) {
            const float* cf = CF + (size_t)m * 1792;
            { const GAS f32x4* p = (const GAS f32x4*)cf + F.lane; f32x4 v[4]; float s = 0.f;
#pragma unroll
              for (int j = 0; j < 4; ++j) { v[j] = p[64 * j]; s += (v[j].x * v[j].x + v[j].y * v[j].y) + (v[j].z * v[j].z + v[j].w * v[j].w); }
              const float rs = 1.f / sqrtf(wave_sum(s) * (1.f / 1024.f) + LN_EPS);
#pragma unroll
              for (int j = 0; j < 4; ++j) { const f32x4 gg = ((const GAS f32x4*)q_norm_g)[F.lane + 64 * j]; const f32x4 o = v[j] * rs * gg;
                  ((GAS unsigned long long*)(CQN + (size_t)m * 1024))[F.lane + 64 * j] = (unsigned long long)pk2(o.x, o.y) | ((unsigned long long)pk2(o.z, o.w) << 32); } }
            { const GAS f32x4* p = (const GAS f32x4*)(cf + 1024) + F.lane; f32x4 v[2]; float s = 0.f;
#pragma unroll
              for (int j = 0; j < 2; ++j) { v[j] = p[64 * j]; s += (v[j].x * v[j].x + v[j].y * v[j].y) + (v[j].z * v[j].z + v[j].w * v[j].w); }
              const float rs = 1.f / sqrtf(wave_sum(s) * (1.f / 512.f) + LN_EPS);
#pragma unroll
              for (int j = 0; j < 2; ++j) { const f32x4 gg = ((const GAS f32x4*)kv_norm_g)[F.lane + 64 * j]; const f32x4 o = v[j] * rs * gg;
                  ((GAS unsigned long long*)(CKVN + (size_t)m * 512))[F.lane + 64 * j] = (unsigned long long)pk2(o.x, o.y) | ((unsigned long long)pk2(o.z, o.w) << 32); } }
            if (F.lane < 32) { const float x1 = cf[1536 + 2 * F.lane], x2 = cf[1536 + 2 * F.lane + 1], c = CS[(size_t)m * 64 + F.lane], s = CS[(size_t)m * 64 + 32 + F.lane];
                ((GAS unsigned*)(KROPE + (size_t)m * 64))[F.lane] = pk2(x1 * c - x2 * s, x1 * s + x2 * c); }
        }
        if (BOTH(2)) GRID_BAR();
    }
    if (IN(3)) {
        { pg8::Gemm g{CQN, Wt_uq, MTOK, 3072, 1024}; pg8::StaticOrder S; S.init(MTOK, 3072, F.G, (int)blockIdx.x);
          pg8::EpiQ E{Q, CS};
          pg8::gemm_phase<pg8::EpiQ, pg8::StaticOrder, true, true>(F.lds + RING_OFF, g, S, E); }
        { pg8::Gemm g{CKVN, Wt_ukv, MTOK, 4096, 512}; pg8::StaticOrder S; S.init(MTOK, 4096, F.G, (int)blockIdx.x);
          pg8::EpiPlain E{KV, 4096};
          pg8::gemm_phase<pg8::EpiPlain, pg8::StaticOrder, true, true>(F.lds + RING_OFF, g, S, E); }
        if (BOTH(3)) GRID_BAR();
    }
    if (IN(4)) {
        for (int task = gw; task < MTOK * 16; task += NGW) {
            const int r = task >> 4, h = task & 15, b = r >> 11, t = r & 2047, nk = 64 * ((t >> 6) + 1);
            const unsigned qn = ((const GAS unsigned*)(Q + (size_t)r * 3072 + h * 192))[F.lane];
            const float q0 = bflo(qn), q1 = bfhi(qn), q2 = bf2f(Q[(size_t)r * 3072 + h * 192 + 128 + F.lane]);
            float mx = -INFINITY, l = 0.f, o0 = 0.f, o1 = 0.f;
            const bf16* kvb = KV + (size_t)(b * 2048) * 4096 + h * 256; const bf16* krb = KROPE + (size_t)(b * 2048) * 64;
            for (int j = 0; j < nk; ++j) {
                const unsigned kn = ((const GAS unsigned*)(kvb + (size_t)j * 4096))[F.lane]; const float kr = bf2f(krb[(size_t)j * 64 + F.lane]);
                const unsigned vv = ((const GAS unsigned*)(kvb + (size_t)j * 4096 + 128))[F.lane];
                const float s = wave_sum(q0 * bflo(kn) + q1 * bfhi(kn) + q2 * kr);
                const float mn = fmaxf(mx, s), corr = exp2f(mx - mn), p = exp2f(s - mn);
                l = l * corr + p; o0 = o0 * corr + p * bflo(vv); o1 = o1 * corr + p * bfhi(vv); mx = mn;
            }
            const float il = 1.f / l;
            ((GAS unsigned*)(OAB + (size_t)r * 2048 + h * 128))[F.lane] = pk2(o0 * il, o1 * il);
        }
        for (int bh = blockIdx.x; bh < 64; bh += F.G) {
            const int b = bh >> 4, h = bh & 15;
            LAS float* sf = (LAS float*)(F.lds + RING_OFF); LAS float* sk = sf + 16 * 128; LAS float* sq = sk + 16 * 128; LAS float* so = sq + 16 * 128;
            float S[128];
#pragma unroll
            for (int k = 0; k < 128; ++k) S[k] = 0.f;
            for (int t0 = 0; t0 < 2048; t0 += 16) {
#pragma unroll
                for (int i = 0; i < 4; ++i) { const int idx = F.tid + 512 * i, tt = idx >> 7, k = idx & 127; const size_t off = (size_t)(b * 2048 + t0 + tt) * 2048 + h * 128 + k;
                    const float f = __expf(GL[off]); sf[idx] = f; sk[idx] = 1.f - f; sq[idx] = bf2f(QH[off]); }
                __syncthreads();
                if (F.tid < 128) {
                    for (int tt = 0; tt < 16; ++tt) {
                        const float vv = bf2f(HI[(size_t)(b * 2048 + t0 + tt) * 2048 + h * 128 + F.tid]); float o = 0.f;
#pragma unroll
                        for (int k = 0; k < 128; ++k) { S[k] = sf[tt * 128 + k] * S[k] + sk[tt * 128 + k] * vv; o += S[k] * sq[tt * 128 + k]; }
                        so[tt * 128 + F.tid] = o;
                    }
                }
                __syncthreads();
                { const int tt = F.tid >> 5, v4 = (F.tid & 31) * 4; const f32x4 o = *(LAS f32x4*)(so + tt * 128 + v4);
                  float s = (o.x * o.x + o.y * o.y) + (o.z * o.z + o.w * o.w);
#pragma unroll
                  for (int d = 1; d < 32; d <<= 1) s += __shfl_xor(s, d);
                  const float rs = 1.f / sqrtf(s * (1.f / 128.f) + LN_EPS);
                  const size_t off = (size_t)(b * 2048 + t0 + tt) * 2048 + h * 128 + v4;
                  const f32x4 gn = *(const f32x4*)(hg_norm_g + v4); const unsigned long long gsw = *(const GAS unsigned long long*)(GS + off);
                  const unsigned g01 = (unsigned)gsw, g23 = (unsigned)(gsw >> 32);
                  const float r0 = o.x * rs * gn.x * bflo(g01), r1 = o.y * rs * gn.y * bfhi(g01), r2 = o.z * rs * gn.z * bflo(g23), r3 = o.w * rs * gn.w * bfhi(g23);
                  *(GAS unsigned long long*)(OAB + (size_t)MTOK * 2048 + off) = (unsigned long long)pk2(r0, r1) | ((unsigned long long)pk2(r2, r3) << 32); }
                __syncthreads();
            }
        }
        if (BOTH(4)) GRID_BAR();
    }
    if (IN(5)) {
        pg8::Gemm g{OAB, Wt_ab, 2 * MTOK, 8192, 2048}; pg8::DualOrder S; S.S.init(MTOK, 4096, F.G, (int)blockIdx.x);
        pg8::EpiMerge E{GA, GB, MERGED};
        pg8::gemm_phase<pg8::EpiMerge, pg8::DualOrder, true, true>(F.lds + RING_OFF, g, S, E);
        if (BOTH(5)) GRID_BAR();
    }
    if (IN(6)) {
        pg8::Gemm g{MERGED, Wt_out, MTOK, 4096, 4096}; pg8::StaticOrder S; S.init(MTOK, 4096, F.G, (int)blockIdx.x);
        pg8::EpiMix E{x, ST, ln_in_g, ln_in_b, R, ALPHA};
        pg8::gemm_phase<pg8::EpiMix, pg8::StaticOrder, true, true>(F.lds + RING_OFF, g, S, E);
        if (BOTH(6)) GRID_BAR();
    }
    if (IN(7)) {
        for (int m = gw; m < MTOK; m += NGW) ln_row<true, true, false>(R + (size_t)m * DM, ln1_g, ln1_b, R + (size_t)m * DM, HB + (size_t)m * DM, nullptr, F.lane);
        if (BOTH(7)) GRID_BAR();
    }
    if (IN(8)) {
        pg8::Gemm g{HB, Wt_gu, MTOK, 2 * DFF, DM}; pg8::StaticOrder S; S.init(MTOK, 2 * DFF, F.G, (int)blockIdx.x);
        pg8::EpiSwiglu E{ACT};
        pg8::gemm_phase<pg8::EpiSwiglu, pg8::StaticOrder, true, true>(F.lds + RING_OFF, g, S, E);
        if (BOTH(8)) GRID_BAR();
    }
    if (IN(9)) {
        pg8::Gemm g{ACT, Wt_down, MTOK, 4096, DFF}; pg8::StaticOrder S; S.init(MTOK, 4096, F.G, (int)blockIdx.x);
        pg8::EpiDown E{R, out, ALPHA};
        pg8::gemm_phase<pg8::EpiDown, pg8::StaticOrder, true, true>(F.lds + RING_OFF, g, S, E);
        if (BOTH(9)) GRID_BAR();
    }
    if (IN(10)) {
        for (int m = gw; m < MTOK; m += NGW) ln_row<true, false, false>(out + (size_t)m * DM, ln2_g, ln2_b, out + (size_t)m * DM, nullptr, nullptr, F.lane);
    }
#undef IN
#undef BOTH
}

extern "C" void kernel_launch(void* const* d_in, const int* in_sizes, int n_in, void* d_out, int out_size, void* d_ws, size_t ws_size, hipStream_t stream) {
    static int grid = 0;
    if (grid == 0) {
        if (n_in != 21 || out_size != MTOK * DM || ws_size < WS_END) { fprintf(stderr, "kernel_launch: unexpected shapes (n_in %d, out %d, ws %zu, need %zu)\n", n_in, out_size, ws_size, (size_t)WS_END); grid = -1; return; }
        int dev = 0, cus = 0, per_cu = 0;
        if (hipGetDevice(&dev) != hipSuccess || hipDeviceGetAttribute(&cus, hipDeviceAttributeMultiprocessorCount, dev) != hipSuccess) { grid = -1; return; }
        if (hipFuncSetAttribute((const void*)mega_fwd, hipFuncAttributeMaxDynamicSharedMemorySize, LDS_BYTES) != hipSuccess) { fprintf(stderr, "kernel_launch: hipFuncSetAttribute failed\n"); grid = -1; return; }
        if (hipOccupancyMaxActiveBlocksPerMultiprocessor(&per_cu, (const void*)mega_fwd, NWAVES * 64, LDS_BYTES) != hipSuccess || per_cu < 1)
            fprintf(stderr, "kernel_launch: note: occupancy query reports %d workgroups per CU\n", per_cu);
        (void)hipGetLastError();
        grid = cus;
    }
    if (grid < 0) return;
    if (hipMemsetAsync((char*)d_ws + WS_CTL, 0, CTL_ZERO_BYTES, stream) != hipSuccess) return;
    Args a{};
    for (int i = 0; i < 21; ++i) a.in[i] = d_in[i];
    a.out = (float*)d_out; a.ws = (unsigned char*)d_ws;
#if MK_ONE_LAUNCH
    a.ph_lo = 0; a.ph_hi = NPHASE;
    hipLaunchKernelGGL(mega_fwd, dim3(grid), dim3(NWAVES * 64), LDS_BYTES, stream, a);
#else
    for (int p = 0; p < NPHASE; ++p) { a.ph_lo = p; a.ph_hi = p + 1; hipLaunchKernelGGL(mega_fwd, dim3(grid), dim3(NWAVES * 64), LDS_BYTES, stream, a); }
#endif
}
```

```cpp
#include <hip/hip_runtime.h>
#include <cstdio>
#include <cstdint>
namespace pg8 {
#define PG8_LAS __attribute__((address_space(3)))
typedef unsigned short bf16_t;
typedef short bf16x8 __attribute__((ext_vector_type(8)));
typedef float f32x4 __attribute__((ext_vector_type(4)));
typedef unsigned u32x4 __attribute__((ext_vector_type(4)));
constexpr int BM = 256, BK = 64, HALF = 128, HTB = HALF * BK * 2  , STAGE_BYTES = 8 * HTB, NXCD = 8, WGM = 8;

__host__ __device__ __forceinline__ int lds_byte(int r, int c) { const int st = (r >> 4) * 2 + (c >> 5), rr = r & 15, cc = c & 31, ob = rr * 64 + cc * 2; return st * 1024 + (ob ^ (((ob >> 9) & 1) << 5)); }
__host__ __device__ __forceinline__ void stage_rc(int b, int& R, int& C) { const int st = b / 1024, sb = b % 1024, swz = sb ^ (((sb >> 9) & 1) << 5); R = (st >> 1) * 16 + swz / 64; C = (st & 1) * 32 + (swz % 64) / 2; }
__host__ __device__ __forceinline__ int perm32(int rho) { const int n = rho >> 4, i = rho & 15; return 8 * (i >> 2) + 4 * n + (i & 3); }

struct Unit { int pm, pn; };
struct Gemm { const bf16_t* A; const bf16_t* Bt; int M, N, K; };

struct StaticOrder {
    int nM, nN, nwg, G, c;
    __host__ __device__ void init(int M, int N, int G_, int c_) { nM = M / BM; nN = N / BM; nwg = nM * nN; G = G_; c = c_; }
    __host__ __device__ bool next(int i, Unit& u) const {
        const long L = (long)i * G + c; if (L >= nwg) return false;
        int wgid = (int)L; { const int q = nwg / NXCD, r = nwg % NXCD, xcd = wgid % NXCD, off = wgid / NXCD; wgid = (xcd < r ? xcd * (q + 1) : r * (q + 1) + (xcd - r) * q) + off; }
        const int nig = WGM * nN, gid = wgid / nig, fm = gid * WGM, gsz = (nM - fm) < WGM ? (nM - fm) : WGM;
        u.pm = fm + ((wgid % nig) % gsz); u.pn = (wgid % nig) / gsz; return true;
    }
    __device__ __forceinline__ void a_ready(const Unit&) const {}
    __device__ __forceinline__ void done(const Unit&) const {}
};

__device__ __forceinline__ unsigned cvt_pk_bf16(float lo, float hi) { unsigned r; asm volatile("v_cvt_pk_bf16_f32 %0, %1, %2" : "=v"(r) : "v"(lo), "v"(hi)); return r; }
typedef float f32x2 __attribute__((ext_vector_type(2)));
__device__ __forceinline__ f32x2 gelu_pk(f32x2 v) {
    const f32x2 av = __builtin_elementwise_abs(v), d = av * 0.2316418882f + 1.0f;
    f32x2 t; t.x = __builtin_amdgcn_rcpf(d.x); t.y = __builtin_amdgcn_rcpf(d.y);
    f32x2 q = t * 0.5307027145f + (-0.7265760135f); q = q * t + 0.7107068705f; q = q * t + (-0.142248368f); q = q * t + 0.127414796f; q = q * t;
    const f32x2 s = (v * v) * (-0.72134752044f);
    f32x2 e; e.x = __builtin_amdgcn_exp2f(s.x); e.y = __builtin_amdgcn_exp2f(s.y);
    const f32x2 m = v * (q * e), r = v - m;
    f32x2 o; o.x = v.x < 0.f ? m.x : r.x; o.y = v.y < 0.f ? m.y : r.y; return o;
}

template <class Epi, class Sched, bool ALIGN_EPI = false, bool SP2 = false>
__device__ __forceinline__ void gemm_phase(PG8_LAS unsigned char* lds, const Gemm g, const Sched& S, const Epi& E) {
    const int tid = threadIdx.x, wid = __builtin_amdgcn_readfirstlane(tid >> 6), lane = tid & 63, wr = wid >> 2, wc = wid & 3, fr = lane & 15, fq = lane >> 4;
    const int K = g.K, nt = K / BK;
    unsigned voffA[2], voffB[2];
#pragma unroll
    for (int i = 0; i < 2; ++i) { int R, C; stage_rc(tid * 16 + i * 8192, R, C); const int Rb = Epi::PERM ? ((R & ~31) + perm32(R & 31)) : R;
        voffA[i] = (unsigned)(R * K + C) * 2u; voffB[i] = (unsigned)(Rb * K + C) * 2u; }
    const size_t kstep = (size_t)(BK * 2);
    const size_t hstep = (size_t)HALF * K * 2;
    const size_t tstep = 2 * hstep;
    const unsigned ldsw = (unsigned)wid * 1024u;
    const int aoff = lds_byte(wr * 64 + fr, fq * 8), boff = lds_byte(wc * 32 + fr, fq * 8);
#define PG8_SA(b, h) (((b) * 2 + (h)) * HTB)
#define PG8_SB(b, h) ((4 + (b) * 2 + (h)) * HTB)
#define PG8_STAGE(bufoff, gbase, voff) do { _Pragma("unroll") for (int _i = 0; _i < 2; ++_i) \
        __builtin_amdgcn_global_load_lds((const unsigned*)((const char*)(gbase) + (voff)[_i]), (PG8_LAS unsigned*)(lds + (bufoff) + ldsw + _i * 8192), 16, 0, 0); } while (0)
#define PG8_LDA(dst, b, h) do { _Pragma("unroll") for (int m = 0; m < 4; ++m) _Pragma("unroll") for (int k = 0; k < 2; ++k) dst[m][k] = *(const PG8_LAS bf16x8*)(lds + PG8_SA(b, h) + aoff + m * 2048 + k * 1024); } while (0)
#define PG8_LDB(dst, b, h) do { _Pragma("unroll") for (int n = 0; n < 2; ++n) _Pragma("unroll") for (int k = 0; k < 2; ++k) dst[n][k] = *(const PG8_LAS bf16x8*)(lds + PG8_SB(b, h) + boff + n * 2048 + k * 1024); } while (0)
#define PG8_MMA(ai, bj, At, Bt) do { __builtin_amdgcn_s_setprio(1); _Pragma("unroll") for (int m = 0; m < 4; ++m) _Pragma("unroll") for (int n = 0; n < 2; ++n) _Pragma("unroll") for (int k = 0; k < 2; ++k) \
        acc[ai][bj][m][n] = __builtin_amdgcn_mfma_f32_16x16x32_bf16(Bt[n][k], At[m][k], acc[ai][bj][m][n], 0, 0, 0); __builtin_amdgcn_s_setprio(0); } while (0)
#define PG8_WAIT_V(n) asm volatile("s_waitcnt vmcnt(" #n ")" ::: "memory")
#define PG8_WAIT_L(n) asm volatile("s_waitcnt lgkmcnt(" #n ")" ::: "memory")
#define PG8_BAR __builtin_amdgcn_s_barrier()
#define PG8_SCHED __builtin_amdgcn_sched_barrier(0)
    Unit cur, nxt; int ui = 0;
    if (!S.next(0, cur)) return;
    f32x4 acc[2][2][4][2];
#pragma unroll
    for (int a = 0; a < 2; ++a)
#pragma unroll
        for (int b = 0; b < 2; ++b)
#pragma unroll
            for (int m = 0; m < 4; ++m)
#pragma unroll
                for (int n = 0; n < 2; ++n) acc[a][b][m][n] = (f32x4){0.f, 0.f, 0.f, 0.f};
    bf16x8 At[4][2], B0[2][2], B1[2][2];
    const char* cA = (const char*)g.A + (size_t)cur.pm * tstep; const char* cB = (const char*)g.Bt + (size_t)cur.pn * tstep;
    S.a_ready(cur);
    if constexpr (SP2) {
        PG8_STAGE(PG8_SB(0, 0), cB, voffB); PG8_STAGE(PG8_SB(0, 1), cB + hstep, voffB); PG8_STAGE(PG8_SA(0, 0), cA, voffA); PG8_STAGE(PG8_SA(0, 1), cA + hstep, voffA);
        if (wr == 1) PG8_BAR;
        PG8_WAIT_V(2); PG8_BAR;
        PG8_STAGE(PG8_SB(1, 0), cB + kstep, voffB); PG8_STAGE(PG8_SA(1, 0), cA + kstep, voffA); PG8_STAGE(PG8_SB(1, 1), cB + hstep + kstep, voffB);
        PG8_WAIT_V(6); PG8_BAR;
    } else {
        PG8_STAGE(PG8_SB(0, 0), cB, voffB); PG8_STAGE(PG8_SA(0, 0), cA, voffA); PG8_STAGE(PG8_SB(0, 1), cB + hstep, voffB); PG8_STAGE(PG8_SA(0, 1), cA + hstep, voffA);
        if (wr == 1) PG8_BAR;
        PG8_WAIT_V(4); PG8_BAR;
        PG8_STAGE(PG8_SB(1, 0), cB + kstep, voffB); PG8_STAGE(PG8_SA(1, 0), cA + kstep, voffA); PG8_STAGE(PG8_SB(1, 1), cB + hstep + kstep, voffB);
        PG8_WAIT_V(6); PG8_BAR;
    }
    for (;;) {
        const bool has_next = S.next(ui + 1, nxt);
        const char* nA = has_next ? (const char*)g.A + (size_t)nxt.pm * tstep : cA; const char* nB = has_next ? (const char*)g.Bt + (size_t)nxt.pn * tstep : cB;
        for (int t = 0; t < nt; t += 2) {
            const bool last = (t == nt - 2);
            const char* a1 = cA + (size_t)(t + 1) * kstep;
            const char* a2 = last ? nA : cA + (size_t)(t + 2) * kstep; const char* b2 = last ? nB : cB + (size_t)(t + 2) * kstep;
            const char* a3 = a2 + kstep; const char* b3 = b2 + kstep;
            if (last && has_next) S.a_ready(nxt);
            if constexpr (SP2) {
            PG8_LDB(B0, 0, 0); PG8_LDB(B1, 0, 1); PG8_SCHED; PG8_LDA(At, 0, 0); PG8_STAGE(PG8_SA(1, 1), a1 + hstep, voffA);
            PG8_WAIT_V(8); PG8_WAIT_L(0); PG8_BAR; PG8_MMA(0, 0, At, B0); PG8_MMA(0, 1, At, B1); PG8_BAR; PG8_SCHED;
            PG8_LDA(At, 0, 1); PG8_STAGE(PG8_SB(0, 0), b2, voffB); PG8_STAGE(PG8_SB(0, 1), b2 + hstep, voffB); PG8_STAGE(PG8_SA(0, 0), a2, voffA);
            PG8_WAIT_V(8); PG8_WAIT_L(0); PG8_BAR; PG8_MMA(1, 0, At, B0); PG8_MMA(1, 1, At, B1); PG8_BAR; PG8_SCHED;
            PG8_LDB(B0, 1, 0); PG8_LDB(B1, 1, 1); PG8_SCHED; PG8_LDA(At, 1, 0); PG8_STAGE(PG8_SA(0, 1), a2 + hstep, voffA);
            PG8_WAIT_V(8); PG8_WAIT_L(0); PG8_BAR; PG8_MMA(0, 0, At, B0); PG8_MMA(0, 1, At, B1); PG8_BAR; PG8_SCHED;
            PG8_LDA(At, 1, 1); PG8_STAGE(PG8_SB(1, 0), b3, voffB); PG8_STAGE(PG8_SB(1, 1), b3 + hstep, voffB); PG8_STAGE(PG8_SA(1, 0), a3, voffA);
            PG8_WAIT_V(8); PG8_WAIT_L(0); PG8_BAR; PG8_MMA(1, 0, At, B0); PG8_MMA(1, 1, At, B1); PG8_BAR; PG8_SCHED;
            } else {
            PG8_LDB(B0, 0, 0); PG8_SCHED; PG8_LDA(At, 0, 0); PG8_STAGE(PG8_SA(1, 1), a1 + hstep, voffA);
            PG8_WAIT_L(8); PG8_BAR; PG8_WAIT_L(0); PG8_MMA(0, 0, At, B0); PG8_BAR; PG8_SCHED;
            PG8_LDB(B1, 0, 1); PG8_STAGE(PG8_SB(0, 0), b2, voffB);
            PG8_BAR; PG8_WAIT_L(0); PG8_MMA(0, 1, At, B1); PG8_BAR;
            PG8_LDA(At, 0, 1); PG8_STAGE(PG8_SA(0, 0), a2, voffA);
            PG8_BAR; PG8_WAIT_L(0); PG8_MMA(1, 0, At, B0); PG8_BAR; PG8_SCHED;
            PG8_STAGE(PG8_SB(0, 1), b2 + hstep, voffB);
            PG8_WAIT_V(6); PG8_BAR; PG8_MMA(1, 1, At, B1); PG8_BAR;
            PG8_LDB(B0, 1, 0); PG8_SCHED; PG8_LDA(At, 1, 0); PG8_STAGE(PG8_SA(0, 1), a2 + hstep, voffA);
            PG8_WAIT_L(8); PG8_BAR; PG8_WAIT_L(0); PG8_MMA(0, 0, At, B0); PG8_BAR; PG8_SCHED;
            PG8_LDB(B1, 1, 1); PG8_STAGE(PG8_SB(1, 0), b3, voffB);
            PG8_BAR; PG8_WAIT_L(0); PG8_MMA(0, 1, At, B1); PG8_BAR;
            PG8_LDA(At, 1, 1); PG8_STAGE(PG8_SA(1, 0), a3, voffA);
            PG8_BAR; PG8_WAIT_L(0); PG8_MMA(1, 0, At, B0); PG8_BAR; PG8_SCHED;
            PG8_STAGE(PG8_SB(1, 1), b3 + hstep, voffB);
            PG8_WAIT_V(6); PG8_BAR; PG8_MMA(1, 1, At, B1); PG8_BAR;
            }
        }
        if constexpr (ALIGN_EPI) { if (wr == 0) PG8_BAR; }
        if constexpr (!Epi::AFTER_DRAIN) { E(acc, cur, wr, wc, fr, fq); S.done(cur); }
        if (!has_next) break;
        if (!E.keep(cur)) {
#pragma unroll
        for (int a = 0; a < 2; ++a)
#pragma unroll
            for (int b = 0; b < 2; ++b)
#pragma unroll
                for (int m = 0; m < 4; ++m)
#pragma unroll
                    for (int n = 0; n < 2; ++n) acc[a][b][m][n] = (f32x4){0.f, 0.f, 0.f, 0.f};
        }
        cur = nxt; cA = nA; cB = nB; ++ui;
        if constexpr (ALIGN_EPI) { if (wr == 1) PG8_BAR; }
    }
    PG8_WAIT_V(0);
    if constexpr (!ALIGN_EPI) { if (wr == 0) PG8_BAR; }
    PG8_BAR;
    if constexpr (Epi::AFTER_DRAIN) { E.fused(acc, cur, wr, wc, fr, fq, lds, wid, lane); S.done(cur); }
#undef PG8_SA
#undef PG8_SB
#undef PG8_STAGE
#undef PG8_LDA
#undef PG8_LDB
#undef PG8_MMA
#undef PG8_WAIT_V
#undef PG8_WAIT_L
#undef PG8_BAR
#undef PG8_SCHED
}
}

namespace pg8 {
__device__ __forceinline__ float bf2f(unsigned short h) { return __uint_as_float(((unsigned)h) << 16); }
__device__ __forceinline__ float bflo(unsigned w) { return __uint_as_float(w << 16); }
__device__ __forceinline__ float bfhi(unsigned w) { return __uint_as_float(w & 0xffff0000u); }
__device__ __forceinline__ float sigm(float x) { return __builtin_amdgcn_rcpf(1.f + __builtin_amdgcn_exp2f(-1.4426950408889634f * x)); }
__device__ __forceinline__ u32x4 pack8(f32x4 a, f32x4 b) { u32x4 w; w.x = cvt_pk_bf16(a[0], a[1]); w.y = cvt_pk_bf16(a[2], a[3]); w.z = cvt_pk_bf16(b[0], b[1]); w.w = cvt_pk_bf16(b[2], b[3]); return w; }

struct EpiProj {
    static constexpr bool PERM = true, AFTER_DRAIN = false;
    float* CF; bf16_t* QH; float* G; bf16_t* HI; bf16_t* GS; bf16_t* GA; bf16_t* GB; const float* hg_lb;
    __device__ __forceinline__ bool keep(const Unit&) const { return false; }
    __device__ __forceinline__ void operator()(f32x4 (&acc)[2][2][4][2], const Unit& u, int wr, int wc, int fr, int fq) const {
        const int pn = u.pn; int mode, ct, ldc; float* pf = nullptr; bf16_t* ph = nullptr;
        if (pn < 7) { mode = 0; ct = pn; ldc = 1792; pf = CF; }
        else if (pn < 15) { mode = 1; ct = pn - 7; ldc = 2048; ph = QH; }
        else if (pn < 23) { mode = 2; ct = pn - 15; ldc = 2048; pf = G; }
        else if (pn < 31) { mode = 3; ct = pn - 23; ldc = 2048; ph = HI; }
        else if (pn < 39) { mode = 1; ct = pn - 31; ldc = 2048; ph = GS; }
        else if (pn < 55) { mode = 4; ct = pn - 39; ldc = 4096; ph = GA; }
        else { mode = 4; ct = pn - 55; ldc = 4096; ph = GB; }
        const int row0 = u.pm * BM + wr * 64 + fr, col0 = ct * BM + wc * 32 + 8 * fq;
        if (mode == 0) {
#pragma unroll
            for (int ai = 0; ai < 2; ++ai)
#pragma unroll
                for (int m = 0; m < 4; ++m) { float* rowp = pf + (size_t)(row0 + ai * HALF + m * 16) * ldc + col0;
#pragma unroll
                    for (int bj = 0; bj < 2; ++bj) { *(f32x4*)(rowp + bj * HALF) = acc[ai][bj][m][0]; *(f32x4*)(rowp + bj * HALF + 4) = acc[ai][bj][m][1]; } }
        } else if (mode == 2) {
#pragma unroll
            for (int bj = 0; bj < 2; ++bj) {
                f32x4 lb[2];
#pragma unroll
                for (int n = 0; n < 2; ++n) { const f32x4 l0 = *(const f32x4*)(hg_lb + col0 + bj * HALF + 4 * n), l1 = *(const f32x4*)(hg_lb + 2048 + col0 + bj * HALF + 4 * n);
#pragma unroll
                    for (int i = 0; i < 4; ++i) lb[n][i] = sigm(l0[i] - l1[i]); }
#pragma unroll
                for (int ai = 0; ai < 2; ++ai)
#pragma unroll
                    for (int m = 0; m < 4; ++m) { float* rowp = pf + (size_t)(row0 + ai * HALF + m * 16) * ldc + col0 + bj * HALF;
#pragma unroll
                        for (int n = 0; n < 2; ++n) { f32x4 v = acc[ai][bj][m][n], o;
#pragma unroll
                            for (int i = 0; i < 4; ++i) { const float f = lb[n][i] + (1.f - lb[n][i]) * sigm(v[i]); o[i] = __builtin_amdgcn_logf(f) * 0.6931471805599453f; }
                            *(f32x4*)(rowp + 4 * n) = o; } }
            }
        } else {
#pragma unroll
            for (int ai = 0; ai < 2; ++ai)
#pragma unroll
                for (int m = 0; m < 4; ++m) { bf16_t* rowp = ph + (size_t)(row0 + ai * HALF + m * 16) * ldc + col0;
#pragma unroll
                    for (int bj = 0; bj < 2; ++bj) { f32x4 v0 = acc[ai][bj][m][0], v1 = acc[ai][bj][m][1];
                        if (mode == 1) {
#pragma unroll
                            for (int i = 0; i < 4; ++i) { v0[i] = v0[i] * sigm(v0[i]); v1[i] = v1[i] * sigm(v1[i]); } }
                        else if (mode == 4) {
#pragma unroll
                            for (int i = 0; i < 4; ++i) { v0[i] = sigm(v0[i]); v1[i] = sigm(v1[i]); } }
                        *(u32x4*)(rowp + bj * HALF) = pack8(v0, v1); } }
        }
    }
};
struct EpiPlain {
    static constexpr bool PERM = true, AFTER_DRAIN = false;
    bf16_t* O; int ldc;
    __device__ __forceinline__ bool keep(const Unit&) const { return false; }
    __device__ __forceinline__ void operator()(f32x4 (&acc)[2][2][4][2], const Unit& u, int wr, int wc, int fr, int fq) const {
        const int row0 = u.pm * BM + wr * 64 + fr, col0 = u.pn * BM + wc * 32 + 8 * fq;
#pragma unroll
        for (int ai = 0; ai < 2; ++ai)
#pragma unroll
            for (int m = 0; m < 4; ++m) { bf16_t* rowp = O + (size_t)(row0 + ai * HALF + m * 16) * ldc + col0;
#pragma unroll
                for (int bj = 0; bj < 2; ++bj) *(u32x4*)(rowp + bj * HALF) = pack8(acc[ai][bj][m][0], acc[ai][bj][m][1]); }
    }
};
struct EpiQ {
    static constexpr bool PERM = true, AFTER_DRAIN = false;
    bf16_t* Q; const float* CS;
    __device__ __forceinline__ bool keep(const Unit&) const { return false; }
    __device__ __forceinline__ void operator()(f32x4 (&acc)[2][2][4][2], const Unit& u, int wr, int wc, int fr, int fq) const {
        const int row0 = u.pm * BM + wr * 64 + fr;
#pragma unroll
        for (int bj = 0; bj < 2; ++bj) {
            const int gi = u.pn * 8 + bj * 4 + wc, part = gi % 6, col0 = gi * 32 + 8 * fq;
            if (part < 4) {
#pragma unroll
                for (int ai = 0; ai < 2; ++ai)
#pragma unroll
                    for (int m = 0; m < 4; ++m) *(u32x4*)(Q + (size_t)(row0 + ai * HALF + m * 16) * 3072 + col0) = pack8(acc[ai][bj][m][0], acc[ai][bj][m][1]);
            } else {
                const int i0 = (part - 4) * 16 + 4 * fq;
#pragma unroll
                for (int ai = 0; ai < 2; ++ai)
#pragma unroll
                    for (int m = 0; m < 4; ++m) { const int row = row0 + ai * HALF + m * 16;
                        const f32x4 c = *(const f32x4*)(CS + (size_t)row * 64 + i0), s = *(const f32x4*)(CS + (size_t)row * 64 + 32 + i0);
                        const f32x4 v0 = acc[ai][bj][m][0], v1 = acc[ai][bj][m][1]; f32x4 o0, o1;
                        o0[0] = v0[0] * c[0] - v0[1] * s[0]; o0[1] = v0[0] * s[0] + v0[1] * c[0]; o0[2] = v0[2] * c[1] - v0[3] * s[1]; o0[3] = v0[2] * s[1] + v0[3] * c[1];
                        o1[0] = v1[0] * c[2] - v1[1] * s[2]; o1[1] = v1[0] * s[2] + v1[1] * c[2]; o1[2] = v1[2] * c[3] - v1[3] * s[3]; o1[3] = v1[2] * s[3] + v1[3] * c[3];
                        *(u32x4*)(Q + (size_t)row * 3072 + col0) = pack8(o0, o1); }
            }
        }
    }
};
struct EpiMerge {
    static constexpr bool PERM = true, AFTER_DRAIN = false;
    const bf16_t* GA; const bf16_t* GB; bf16_t* O;
    __device__ __forceinline__ bool keep(const Unit& u) const { return u.pm < 32; }
    __device__ __forceinline__ void operator()(f32x4 (&acc)[2][2][4][2], const Unit& u, int wr, int wc, int fr, int fq) const {
        const bool second = u.pm >= 32;
        const int row0 = (u.pm & 31) * BM + wr * 64 + fr, col0 = (u.pn & 15) * BM + wc * 32 + 8 * fq;
#pragma unroll
        for (int ai = 0; ai < 2; ++ai)
#pragma unroll
            for (int m = 0; m < 4; ++m) { const size_t off = (size_t)(row0 + ai * HALF + m * 16) * 4096 + col0;
#pragma unroll
                for (int bj = 0; bj < 2; ++bj) {
                    const u32x4 gb = *(const u32x4*)(GB + off + bj * HALF);
                    f32x4 b0, b1; b0[0] = bflo(gb.x); b0[1] = bfhi(gb.x); b0[2] = bflo(gb.y); b0[3] = bfhi(gb.y); b1[0] = bflo(gb.z); b1[1] = bfhi(gb.z); b1[2] = bflo(gb.w); b1[3] = bfhi(gb.w);
#pragma unroll
                    for (int i = 0; i < 4; ++i) { b0[i] = fmaxf(b0[i], 1e-30f); b1[i] = fmaxf(b1[i], 1e-30f); }
                    if (!second) {
                        const u32x4 ga = *(const u32x4*)(GA + off + bj * HALF);
                        f32x4 a0, a1; a0[0] = bflo(ga.x); a0[1] = bfhi(ga.x); a0[2] = bflo(ga.y); a0[3] = bfhi(ga.y); a1[0] = bflo(ga.z); a1[1] = bfhi(ga.z); a1[2] = bflo(ga.w); a1[3] = bfhi(ga.w);
#pragma unroll
                        for (int i = 0; i < 4; ++i) { acc[ai][bj][m][0][i] *= a0[i] * __builtin_amdgcn_rcpf(b0[i]); acc[ai][bj][m][1][i] *= a1[i] * __builtin_amdgcn_rcpf(b1[i]); }
                    } else {
                        *(u32x4*)(O + off + bj * HALF) = pack8(acc[ai][bj][m][0] * b0, acc[ai][bj][m][1] * b1);
                    }
                } }
    }
};
struct DualOrder {
    StaticOrder S;
    __device__ __forceinline__ bool next(int i, Unit& u) const { if (!S.next(i >> 1, u)) return false; if (i & 1) { u.pm += 32; u.pn += 16; } return true; }
    __device__ __forceinline__ void a_ready(const Unit&) const {}
    __device__ __forceinline__ void done(const Unit&) const {}
};
struct EpiMix {
    static constexpr bool PERM = false, AFTER_DRAIN = false;
    const float* X; const float* ST; const float* g; const float* b; float* Y; float alpha;
    __device__ __forceinline__ bool keep(const Unit&) const { return false; }
    __device__ __forceinline__ void operator()(f32x4 (&acc)[2][2][4][2], const Unit& u, int wr, int wc, int fr, int fq) const {
        const int row0 = u.pm * BM + wr * 64 + fr, col0 = u.pn * BM + wc * 32 + 4 * fq;
#pragma unroll
        for (int ai = 0; ai < 2; ++ai)
#pragma unroll
            for (int m = 0; m < 4; ++m) { const int row = row0 + ai * HALF + m * 16; const float mu = ST[2 * row], rs = ST[2 * row + 1]; const size_t off = (size_t)row * 4096 + col0;
#pragma unroll
                for (int bj = 0; bj < 2; ++bj)
#pragma unroll
                    for (int n = 0; n < 2; ++n) { const int cc = bj * HALF + n * 16; const f32x4 xv = *(const f32x4*)(X + off + cc), gv = *(const f32x4*)(g + col0 + cc), bv = *(const f32x4*)(b + col0 + cc);
                        *(f32x4*)(Y + off + cc) = ((xv - mu) * rs * gv + bv) * alpha + acc[ai][bj][m][n]; } }
    }
};
struct EpiSwiglu {
    static constexpr bool PERM = true, AFTER_DRAIN = false;
    bf16_t* O;
    __device__ __forceinline__ bool keep(const Unit&) const { return false; }
    __device__ __forceinline__ void operator()(f32x4 (&acc)[2][2][4][2], const Unit& u, int wr, int wc, int fr, int fq) const {
        const int row0 = u.pm * BM + wr * 64 + fr, col0 = u.pn * HALF + wc * 32 + 8 * fq;
#pragma unroll
        for (int ai = 0; ai < 2; ++ai)
#pragma unroll
            for (int m = 0; m < 4; ++m) { f32x4 o0, o1;
#pragma unroll
                for (int i = 0; i < 4; ++i) { const float g0 = acc[ai][0][m][0][i], g1 = acc[ai][0][m][1][i]; o0[i] = g0 * sigm(g0) * acc[ai][1][m][0][i]; o1[i] = g1 * sigm(g1) * acc[ai][1][m][1][i]; }
                *(u32x4*)(O + (size_t)(row0 + ai * HALF + m * 16) * 11008 + col0) = pack8(o0, o1); }
    }
};
struct EpiDown {
    static constexpr bool PERM = false, AFTER_DRAIN = false;
    const float* H1; float* Z; float alpha;
    __device__ __forceinline__ bool keep(const Unit&) const { return false; }
    __device__ __forceinline__ void operator()(f32x4 (&acc)[2][2][4][2], const Unit& u, int wr, int wc, int fr, int fq) const {
        const int row0 = u.pm * BM + wr * 64 + fr, col0 = u.pn * BM + wc * 32 + 4 * fq;
#pragma unroll
        for (int ai = 0; ai < 2; ++ai)
#pragma unroll
            for (int m = 0; m < 4; ++m) { const size_t off = (size_t)(row0 + ai * HALF + m * 16) * 4096 + col0;
#pragma unroll
                for (int bj = 0; bj < 2; ++bj)
#pragma unroll
                    for (int n = 0; n < 2; ++n) { const int cc = bj * HALF + n * 16; *(f32x4*)(Z + off + cc) = *(const f32x4*)(H1 + off + cc) * alpha + acc[ai][bj][m][n]; } }
    }
};
}

#ifndef MK_ONE_LAUNCH
#define MK_ONE_LAUNCH 1
#endif
constexpr int NWAVES = 8;
constexpr int NPHASE = 11;
constexpr int MTOK = 8192, DM = 4096, DFF = 11008, NPROJ = 18176;
constexpr float LN_EPS = 1e-5f;
constexpr float ALPHA = 1.189207115002721f;
constexpr float QSCALE = 0.07216878364870322f * 1.4426950408889634f;
constexpr size_t MiB = 1u << 20;
constexpr size_t WS_CTL = 0, CTL_ZERO_BYTES = 1 * MiB;
constexpr size_t WS_CS = 1 * MiB;
constexpr size_t WS_ST = 3 * MiB;
constexpr size_t WS_WIN = 8 * MiB;
constexpr size_t WS_Q = 8 * MiB;
constexpr size_t WS_KV = 56 * MiB;
constexpr size_t WS_CQN = 120 * MiB;
constexpr size_t WS_CKVN = 136 * MiB;
constexpr size_t WS_KROPE = 144 * MiB;
constexpr size_t WS_WUQ = 150 * MiB, WS_WUKV = 156 * MiB, WS_WAB = 160 * MiB, WS_WOUT = 192 * MiB, WS_WGU = 224 * MiB, WS_WDOWN = 396 * MiB;
constexpr size_t WS_HB = 482 * MiB;
constexpr size_t WS_CF = 546 * MiB;
constexpr size_t WS_QH = 602 * MiB, WS_G = 634 * MiB, WS_HI = 698 * MiB, WS_GS = 730 * MiB, WS_GA = 762 * MiB, WS_GB = 826 * MiB;
constexpr size_t WS_R = 546 * MiB;
constexpr size_t WS_ACT = 674 * MiB;
constexpr size_t WS_OAB = 890 * MiB;
constexpr size_t WS_END = 954 * MiB;
static_assert(WS_WIN + (size_t)NPROJ * DM * 2 <= WS_WUQ && WS_KROPE + (size_t)MTOK * 64 * 2 <= WS_WUQ, "ws map 1");
static_assert(WS_WGU + (size_t)2 * DFF * DM * 2 <= WS_WDOWN && WS_WDOWN + (size_t)DFF * DM * 2 <= WS_HB, "ws map 2");
static_assert(WS_CF + (size_t)MTOK * 1792 * 4 <= WS_QH && WS_R + (size_t)MTOK * DM * 4 <= WS_ACT && WS_ACT + (size_t)MTOK * DFF * 2 <= WS_OAB, "ws map 3");
constexpr int CW_BAR = 4096;
constexpr int RING_OFF = 0, RING_BYTES = 131072;
constexpr int LDSCTL_OFF = RING_BYTES, MISC_OFF = LDSCTL_OFF + 320;
constexpr int LDS_BYTES = 147456;
#define GAS __attribute__((address_space(1)))
#define LAS __attribute__((address_space(3)))
typedef unsigned short bf16;
typedef unsigned v4u __attribute__((ext_vector_type(4)));
typedef float f32x4 __attribute__((ext_vector_type(4)));
typedef short bf16x8 __attribute__((ext_vector_type(8)));
typedef GAS unsigned gu32;
typedef GAS unsigned long long gu64;
#define RLX_AGENT __ATOMIC_RELAXED, __HIP_MEMORY_SCOPE_AGENT
#define LDS_WAIT() asm volatile("s_waitcnt lgkmcnt(0)" ::: "memory")
#define VM_WAIT() asm volatile("s_waitcnt vmcnt(0)" ::: "memory")
__device__ __forceinline__ unsigned long long rt() { return __builtin_amdgcn_s_memrealtime(); }
__device__ __forceinline__ unsigned f2bf(float f) { unsigned u = __builtin_bit_cast(unsigned, f); return (u + 0x7fffu + ((u >> 16) & 1u)) >> 16; }
__device__ __forceinline__ unsigned pk2(float lo, float hi) { return f2bf(lo) | (f2bf(hi) << 16); }

#define XB_TMO      128
#define XB_XCNT(j)  (256  + 64 * (j))
#define XB_XSUB(j)  (1280 + 64 * (j))
#define XB_XGEN(j)  (2304 + 64 * (j))
#define XB_TOP      3328
#define XB_TOPGEN   3392
#define XCD_BAR_WORDS 3456
#define XB_SPIN_CAP (1u << 18)

__device__ __forceinline__ unsigned xb_ld(unsigned* p)              { return __hip_atomic_load(p, __ATOMIC_RELAXED, __HIP_MEMORY_SCOPE_AGENT); }
__device__ __forceinline__ unsigned xb_add(unsigned* p, unsigned v) { return __hip_atomic_fetch_add(p, v, __ATOMIC_RELAXED, __HIP_MEMORY_SCOPE_AGENT); }
__device__ __forceinline__ unsigned xb_xcc_id() { return (unsigned)__builtin_amdgcn_s_getreg((3 << 11) | 20) & 0xFu; }
#define XB_SPIN(cond, bar) do { unsigned _sp = 0; while (cond) { __builtin_amdgcn_s_sleep(1); \
    if ((++_sp & 255u) == 0u) { if (xb_ld(&(bar)[XB_TMO])) break; if (_sp > XB_SPIN_CAP) { atomicAdd(&(bar)[XB_TMO], 1u); break; } } } } while (0)

struct XcdBarrier {
    unsigned* bar; unsigned x;
    volatile LAS unsigned* st;
};

__device__ __forceinline__ XcdBarrier xcd_barrier_post(unsigned* bar, volatile LAS unsigned* st) {
    XcdBarrier b; b.bar = bar; b.x = xb_xcc_id(); b.st = st;
    if (threadIdx.x == 0) (void)xb_add(&bar[XB_XCNT(b.x)], 1u);
    return b;
}
__device__ __forceinline__ void xcd_barrier_complete(unsigned* bar, unsigned x, unsigned& nloc, unsigned& nx) {
    const unsigned G = gridDim.x * gridDim.y * gridDim.z;
    unsigned sum, cnt, mine, sp = 0u;
    for (;;) {
        sum = 0u; cnt = 0u; mine = 0u;
#pragma unroll
        for (unsigned j = 0; j < 16; ++j) { const unsigned c = xb_ld(&bar[XB_XCNT(j)]); sum += c; cnt += (c > 0u) ? 1u : 0u; mine = (j == x) ? c : mine; }
        if (sum == G) break;
        __builtin_amdgcn_s_sleep(1);
        if ((++sp & 255u) == 0u) { if (xb_ld(&bar[XB_TMO])) break; if (sp > XB_SPIN_CAP) { atomicAdd(&bar[XB_TMO], 1u); break; } }
    }
    nloc = mine > 0u ? mine : 1u; nx = cnt > 0u ? cnt : 1u;
}

__device__ __forceinline__ void xcd_barrier(const XcdBarrier& b) {
    asm volatile("s_waitcnt vmcnt(0)" ::: "memory");
    __syncthreads();
    if (threadIdx.x == 0) {
        unsigned* bar = b.bar;
        __builtin_amdgcn_s_waitcnt(0);
        unsigned nloc = b.st[0], nx = b.st[1];
        if (nloc == 0u) { xcd_barrier_complete(bar, b.x, nloc, nx); b.st[0] = nloc; b.st[1] = nx; }
        const unsigned old = xb_add(&bar[XB_XSUB(b.x)], 1u);
        const unsigned gen = old / nloc;
        if (old + 1u == (gen + 1u) * nloc) {
            __builtin_amdgcn_fence(__ATOMIC_RELEASE, "agent");
            asm volatile("s_waitcnt vmcnt(0)" ::: "memory");
            const unsigned og = xb_add(&bar[XB_TOP], 1u);
            const unsigned tg = og / nx;
            if (og + 1u == (tg + 1u) * nx) xb_add(&bar[XB_TOPGEN], 1u);
            else XB_SPIN(xb_ld(&bar[XB_TOPGEN]) == tg, bar);
            __builtin_amdgcn_fence(__ATOMIC_ACQUIRE, "agent");
            xb_add(&bar[XB_XGEN(b.x)], 1u);
            asm volatile("s_waitcnt vmcnt(0)" ::: "memory");
        } else {
            XB_SPIN(xb_ld(&bar[XB_XGEN(b.x)]) == gen, bar);
            __builtin_amdgcn_fence(__ATOMIC_ACQUIRE, "agent");
            asm volatile("s_waitcnt vmcnt(0)" ::: "memory");
        }
    }
    __syncthreads();
}

struct Frame {
    LAS unsigned char* lds;
    volatile LAS unsigned* MISC;
    gu32* ctl;
    int tid, lane, wave, vcu, G;
};
__device__ __forceinline__ float wave_sum(float v) {
#pragma unroll
    for (int o = 1; o < 64; o <<= 1) v += __shfl_xor(v, o);
    return v;
}
__device__ __forceinline__ float bf2f(bf16 h) { return __uint_as_float(((unsigned)h) << 16); }
__device__ __forceinline__ float bflo(unsigned w) { return __uint_as_float(w << 16); }
__device__ __forceinline__ float bfhi(unsigned w) { return __uint_as_float(w & 0xffff0000u); }

template <class RowMap>
__device__ __forceinline__ void p0_transpose_item(const float* W, int K, int N, bf16* WT, const RowMap rm, float scale, LAS float* scr, int item, int lane) {
    const int nblk = N / 32, kb = item / nblk, nb = item % nblk, k0 = 64 * kb, n0 = 32 * nb;
#pragma unroll 8
    for (int i = 0; i < 32; ++i) { const int kk = 2 * i + (lane >> 5); scr[kk * 33 + (lane & 31)] = W[(size_t)(k0 + kk) * N + n0 + (lane & 31)]; }
    LDS_WAIT(); asm volatile("" ::: "memory");
    const int c = lane & 7;
#pragma unroll
    for (int j = 0; j < 4; ++j) { const int n = (lane >> 3) + 8 * j; const LAS float* s = scr + (8 * c) * 33 + n;
        v4u o; o.x = pk2(s[0 * 33] * scale, s[1 * 33] * scale); o.y = pk2(s[2 * 33] * scale, s[3 * 33] * scale); o.z = pk2(s[4 * 33] * scale, s[5 * 33] * scale); o.w = pk2(s[6 * 33] * scale, s[7 * 33] * scale);
        *(GAS v4u*)(WT + (size_t)rm(n0 + n) * K + k0 + 8 * c) = o; }
    LDS_WAIT(); asm volatile("" ::: "memory");
}
struct RmId { int off; __device__ __forceinline__ int operator()(int n) const { return n + off; } };
struct RmWin { __device__ __forceinline__ int operator()(int n) const { if (n < 1536) return n; if (n < 1600) { const int i = n - 1536; return 1536 + ((i & 31) << 1) + (i >> 5); } return n + 192; } };
struct RmUq { __device__ __forceinline__ int operator()(int n) const { const int hd = n / 192, w = n - hd * 192; if (w < 128) return n; const int i = w - 128; return hd * 192 + 128 + ((i & 31) << 1) + (i >> 5); } };
struct RmGu { int up; __device__ __forceinline__ int operator()(int n) const { return ((n >> 7) << 8) + (n & 127) + up; } };

template <bool WF32, bool WBF, bool WST>
__device__ __forceinline__ void ln_row(const float* xrow, const float* g, const float* b, float* of, bf16* ob, float* st, int lane) {
    const GAS f32x4* xr = (const GAS f32x4*)xrow + lane;
    f32x4 v[16]; float s = 0.f;
#pragma unroll
    for (int j = 0; j < 16; ++j) { v[j] = xr[64 * j]; s += (v[j].x + v[j].y) + (v[j].z + v[j].w); }
    const float mean = wave_sum(s) * (1.f / 4096.f); float s2 = 0.f;
#pragma unroll
    for (int j = 0; j < 16; ++j) { v[j] = v[j] - mean; s2 += (v[j].x * v[j].x + v[j].y * v[j].y) + (v[j].z * v[j].z + v[j].w * v[j].w); }
    const float rstd = 1.f / sqrtf(wave_sum(s2) * (1.f / 4096.f) + LN_EPS);
    if (WST) { if (lane == 0) { st[0] = mean; st[1] = rstd; } }
    const GAS f32x4* gr = (const GAS f32x4*)g + lane; const GAS f32x4* br = (const GAS f32x4*)b + lane;
#pragma unroll
    for (int j = 0; j < 16; ++j) { const f32x4 o = v[j] * rstd * gr[64 * j] + br[64 * j];
        if (WF32) ((GAS f32x4*)of)[lane + 64 * j] = o;
        if (WBF) ((GAS unsigned long long*)ob)[lane + 64 * j] = (unsigned long long)pk2(o.x, o.y) | ((unsigned long long)pk2(o.z, o.w) << 32); }
}

struct Args { const void* in[21]; float* out; unsigned char* ws; int ph_lo, ph_hi; };
__global__ void __launch_bounds__(NWAVES * 64, 2) mega_fwd(Args args) {
    extern __shared__ __attribute__((aligned(16))) unsigned char lds[];
    Frame F;
    F.lds = (LAS unsigned char*)lds;
    F.MISC = (volatile LAS unsigned*)(F.lds + MISC_OFF);
    F.tid = threadIdx.x; F.lane = F.tid & 63; F.wave = __builtin_amdgcn_readfirstlane(F.tid >> 6);
    F.G = gridDim.x; { const int bx = blockIdx.x; F.vcu = (F.G % 8 == 0) ? (bx % 8) * (F.G / 8) + bx / 8 : bx; }
    unsigned char* ws = args.ws;
    F.ctl = (gu32*)(ws + WS_CTL);
    const float* x = (const float*)args.in[0]; const int* positions = (const int*)args.in[1];
    const float* ln_in_g = (const float*)args.in[2]; const float* ln_in_b = (const float*)args.in[3];
    const float* w_in = (const float*)args.in[4]; const float* q_norm_g = (const float*)args.in[5]; const float* w_uq = (const float*)args.in[6];
    const float* kv_norm_g = (const float*)args.in[7]; const float* w_ukv = (const float*)args.in[8]; const float* hg_lb = (const float*)args.in[9];
    const float* hg_norm_g = (const float*)args.in[10]; const float* w_a = (const float*)args.in[11]; const float* w_b = (const float*)args.in[12];
    const float* w_out = (const float*)args.in[13]; const float* ln1_g = (const float*)args.in[14]; const float* ln1_b = (const float*)args.in[15];
    const float* w_gate = (const float*)args.in[16]; const float* w_up = (const float*)args.in[17]; const float* w_down = (const float*)args.in[18];
    const float* ln2_g = (const float*)args.in[19]; const float* ln2_b = (const float*)args.in[20];
    float* out = args.out;
    bf16* Wt_in = (bf16*)(ws + WS_WIN); bf16* Wt_uq = (bf16*)(ws + WS_WUQ); bf16* Wt_ukv = (bf16*)(ws + WS_WUKV); bf16* Wt_ab = (bf16*)(ws + WS_WAB);
    bf16* Wt_out = (bf16*)(ws + WS_WOUT); bf16* Wt_gu = (bf16*)(ws + WS_WGU); bf16* Wt_down = (bf16*)(ws + WS_WDOWN);
    bf16* HB = (bf16*)(ws + WS_HB); float* CS = (float*)(ws + WS_CS); float* ST = (float*)(ws + WS_ST);
    float* CF = (float*)(ws + WS_CF); bf16* QH = (bf16*)(ws + WS_QH); float* GL = (float*)(ws + WS_G); bf16* HI = (bf16*)(ws + WS_HI); bf16* GS = (bf16*)(ws + WS_GS);
    bf16* GA = (bf16*)(ws + WS_GA); bf16* GB = (bf16*)(ws + WS_GB);
    bf16* Q = (bf16*)(ws + WS_Q); bf16* KV = (bf16*)(ws + WS_KV); bf16* CQN = (bf16*)(ws + WS_CQN); bf16* CKVN = (bf16*)(ws + WS_CKVN); bf16* KROPE = (bf16*)(ws + WS_KROPE);
    bf16* OAB = (bf16*)(ws + WS_OAB); bf16* MERGED = (bf16*)(ws + WS_KV); float* R = (float*)(ws + WS_R); bf16* ACT = (bf16*)(ws + WS_ACT);

    for (int u = F.tid; u < (LDS_BYTES - LDSCTL_OFF) / 4; u += NWAVES * 64) ((LAS unsigned*)(F.lds + LDSCTL_OFF))[u] = 0u;
    __syncthreads();
#if MK_ONE_LAUNCH
    XcdBarrier bar = xcd_barrier_post((unsigned*)(F.ctl + CW_BAR), F.MISC + 8);
#define GRID_BAR() xcd_barrier(bar)
#else
#define GRID_BAR() do {} while (0)
#endif
    const int lo = args.ph_lo, hi = args.ph_hi;
#define IN(k) (lo <= (k) && (k) < hi)
#define BOTH(k) (IN(k) && IN((k) + 1))
    const int gw = F.vcu * NWAVES + F.wave, NGW = F.G * NWAVES;
    const int gt = blockIdx.x * (NWAVES * 64) + F.tid, NGT = F.G * NWAVES * 64;

    if (IN(0)) {
        LAS float* scr = (LAS float*)(F.lds + RING_OFF + F.wave * 16384);
        constexpr int I_IN = (DM / 64) * (17984 / 32), I_UQ = (1024 / 64) * (3072 / 32), I_UKV = (512 / 64) * (4096 / 32), I_A = (2048 / 64) * (4096 / 32), I_B = I_A,
                      I_OUT = (4096 / 64) * (4096 / 32), I_G = (4096 / 64) * (DFF / 32), I_U = I_G, I_D = (DFF / 64) * (4096 / 32);
        constexpr int NITEMS = I_IN + I_UQ + I_UKV + I_A + I_B + I_OUT + I_G + I_U + I_D;
        for (int it = gw; it < NITEMS; it += NGW) {
            int r = it;
            if (r < I_IN) { p0_transpose_item(w_in, DM, 17984, Wt_in, RmWin{}, 1.f, scr, r, F.lane); continue; } r -= I_IN;
            if (r < I_UQ) { p0_transpose_item(w_uq, 1024, 3072, Wt_uq, RmUq{}, QSCALE, scr, r, F.lane); continue; } r -= I_UQ;
            if (r < I_UKV) { p0_transpose_item(w_ukv, 512, 4096, Wt_ukv, RmId{0}, 1.f, scr, r, F.lane); continue; } r -= I_UKV;
            if (r < I_A) { p0_transpose_item(w_a, 2048, 4096, Wt_ab, RmId{0}, 1.f, scr, r, F.lane); continue; } r -= I_A;
            if (r < I_B) { p0_transpose_item(w_b, 2048, 4096, Wt_ab, RmId{4096}, 1.f, scr, r, F.lane); continue; } r -= I_B;
            if (r < I_OUT) { p0_transpose_item(w_out, 4096, 4096, Wt_out, RmId{0}, 1.f, scr, r, F.lane); continue; } r -= I_OUT;
            if (r < I_G) { p0_transpose_item(w_gate, 4096, DFF, Wt_gu, RmGu{0}, 1.f, scr, r, F.lane); continue; } r -= I_G;
            if (r < I_U) { p0_transpose_item(w_up, 4096, DFF, Wt_gu, RmGu{128}, 1.f, scr, r, F.lane); continue; } r -= I_U;
            p0_transpose_item(w_down, DFF, 4096, Wt_down, RmId{0}, 1.f, scr, r, F.lane);
        }
        for (int i = gt; i < 192 * DM / 8; i += NGT) ((GAS v4u*)(Wt_in + (size_t)1600 * DM))[i] = (v4u){0u, 0u, 0u, 0u};
        for (int m = gw; m < MTOK; m += NGW) ln_row<false, true, true>(x + (size_t)m * DM, ln_in_g, ln_in_b, nullptr, HB + (size_t)m * DM, ST + 2 * m, F.lane);
        for (int i = gt; i < MTOK * 32; i += NGT) { const int row = i >> 5, k = i & 31;
            const float inv = exp2f(-(float)k * (13.287712379549449f / 32.f)); const float ang = (float)positions[row] * inv;
            CS[(size_t)row * 64 + k] = cosf(ang); CS[(size_t)row * 64 + 32 + k] = sinf(ang); }
        if (BOTH(0)) GRID_BAR();
    }
    if (IN(1)) {
        pg8::Gemm g{HB, Wt_in, MTOK, NPROJ, DM}; pg8::StaticOrder S; S.init(MTOK, NPROJ, F.G, (int)blockIdx.x);
        pg8::EpiProj E{CF, QH, GL, HI, GS, GA, GB, hg_lb};
        pg8::gemm_phase<pg8::EpiProj, pg8::StaticOrder, true, true>(F.lds + RING_OFF, g, S, E);
        if (BOTH(1)) GRID_BAR();
    }
    if (IN(2)) {
        for (int m = gw; m < MTOK; m += NGW) {
            const float* cf = CF + (size_t)m * 1792;
            { const GAS f32x4* p = (const GAS f32x4*)cf + F.lane; f32x4 v[4]; float s = 0.f;
#pragma unroll
              for (int j = 0; j < 4; ++j) { v[j] = p[64 * j]; s += (v[j].x * v[j].x + v[j].y * v[j].y) + (v[j].z * v[j].z + v[j].w * v[j].w); }
              const float rs = 1.f / sqrtf(wave_sum(s) * (1.f / 1024.f) + LN_EPS);
#pragma unroll
              for (int j = 0; j < 4; ++j) { const f32x4 gg = ((const GAS f32x4*)q_norm_g)[F.lane + 64 * j]; const f32x4 o = v[j] * rs * gg;
                  ((GAS unsigned long long*)(CQN + (size_t)m * 1024))[F.lane + 64 * j] = (unsigned long long)pk2(o.x, o.y) | ((unsigned long long)pk2(o.z, o.w) << 32); } }
            { const GAS f32x4* p = (const GAS f32x4*)(cf + 1024) + F.lane; f32x4 v[2]; float s = 0.f;
#pragma unroll
              for (int j = 0; j < 2; ++j) { v[j] = p[64 * j]; s += (v[j].x * v[j].x + v[j].y * v[j].y) + (v[j].z * v[j].z + v[j].w * v[j].w); }
              const float rs = 1.f / sqrtf(wave_sum(s) * (1.f / 512.f) + LN_EPS);
#pragma unroll
              for (int j = 0; j < 2; ++j) { const f32x4 gg = ((const GAS f32x4*)kv_norm_g)[F.lane + 64 * j]; const f32x4 o = v[j] * rs * gg;
                  ((GAS unsigned long long*)(CKVN + (size_t)m * 512))[F.lane + 64 * j] = (unsigned long long)pk2(o.x, o.y) | ((unsigned long long)pk2(o.z, o.w) << 32); } }
            if (F.lane < 32) { const float x1 = cf[1536 + 2 * F.lane], x2 = cf[1536 + 2 * F.lane + 1], c = CS[(size_t)m * 64 + F.lane], s = CS[(size_t)m * 64 + 32 + F.lane];
                ((GAS unsigned*)(KROPE + (size_t)m * 64))[F.lane] = pk2(x1 * c - x2 * s, x1 * s + x2 * c); }
        }
        if (BOTH(2)) GRID_BAR();
    }
    if (IN(3)) {
        { pg8::Gemm g{CQN, Wt_uq, MTOK, 3072, 1024}; pg8::StaticOrder S; S.init(MTOK, 3072, F.G, (int)blockIdx.x);
          pg8::EpiQ E{Q, CS};
          pg8::gemm_phase<pg8::EpiQ, pg8::StaticOrder, true, true>(F.lds + RING_OFF, g, S, E); }
        { pg8::Gemm g{CKVN, Wt_ukv, MTOK, 4096, 512}; pg8::StaticOrder S; S.init(MTOK, 4096, F.G, (int)blockIdx.x);
          pg8::EpiPlain E{KV, 4096};
          pg8::gemm_phase<pg8::EpiPlain, pg8::StaticOrder, true, true>(F.lds + RING_OFF, g, S, E); }
        if (BOTH(3)) GRID_BAR();
    }
    if (IN(4)) {
        for (int task = gw; task < MTOK * 16; task += NGW) {
            const int r = task >> 4, h = task & 15, b = r >> 11, t = r & 2047, nk = 64 * ((t >> 6) + 1);
            const unsigned qn = ((const GAS unsigned*)(Q + (size_t)r * 3072 + h * 192))[F.lane];
            const float q0 = bflo(qn), q1 = bfhi(qn), q2 = bf2f(Q[(size_t)r * 3072 + h * 192 + 128 + F.lane]);
            float mx = -INFINITY, l = 0.f, o0 = 0.f, o1 = 0.f;
            const bf16* kvb = KV + (size_t)(b * 2048) * 4096 + h * 256; const bf16* krb = KROPE + (size_t)(b * 2048) * 64;
            for (int j = 0; j < nk; ++j) {
                const unsigned kn = ((const GAS unsigned*)(kvb + (size_t)j * 4096))[F.lane]; const float kr = bf2f(krb[(size_t)j * 64 + F.lane]);
                const unsigned vv = ((const GAS unsigned*)(kvb + (size_t)j * 4096 + 128))[F.lane];
                const float s = wave_sum(q0 * bflo(kn) + q1 * bfhi(kn) + q2 * kr);
                const float mn = fmaxf(mx, s), corr = exp2f(mx - mn), p = exp2f(s - mn);
                l = l * corr + p; o0 = o0 * corr + p * bflo(vv); o1 = o1 * corr + p * bfhi(vv); mx = mn;
            }
            const float il = 1.f / l;
            ((GAS unsigned*)(OAB + (size_t)r * 2048 + h * 128))[F.lane] = pk2(o0 * il, o1 * il);
        }
        for (int bh = blockIdx.x; bh < 64; bh += F.G) {
            const int b = bh >> 4, h = bh & 15;
            LAS float* sf = (LAS float*)(F.lds + RING_OFF); LAS float* sk = sf + 16 * 128; LAS float* sq = sk + 16 * 128; LAS float* so = sq + 16 * 128;
            float S[128];
#pragma unroll
            for (int k = 0; k < 128; ++k) S[k] = 0.f;
            for (int t0 = 0; t0 < 2048; t0 += 16) {
#pragma unroll
                for (int i = 0; i < 4; ++i) { const int idx = F.tid + 512 * i, tt = idx >> 7, k = idx & 127; const size_t off = (size_t)(b * 2048 + t0 + tt) * 2048 + h * 128 + k;
                    const float f = __expf(GL[off]); sf[idx] = f; sk[idx] = 1.f - f; sq[idx] = bf2f(QH[off]); }
                __syncthreads();
                if (F.tid < 128) {
                    for (int tt = 0; tt < 16; ++tt) {
                        const float vv = bf2f(HI[(size_t)(b * 2048 + t0 + tt) * 2048 + h * 128 + F.tid]); float o = 0.f;
#pragma unroll
                        for (int k = 0; k < 128; ++k) { S[k] = sf[tt * 128 + k] * S[k] + sk[tt * 128 + k] * vv; o += S[k] * sq[tt * 128 + k]; }
                        so[tt * 128 + F.tid] = o;
                    }
                }
                __syncthreads();
                { const int tt = F.tid >> 5, v4 = (F.tid & 31) * 4; const f32x4 o = *(LAS f32x4*)(so + tt * 128 + v4);
                  float s = (o.x * o.x + o.y * o.y) + (o.z * o.z + o.w * o.w);
#pragma unroll
                  for (int d = 1; d < 32; d <<= 1) s += __shfl_xor(s, d);
                  const float rs = 1.f / sqrtf(s * (1.f / 128.f) + LN_EPS);
                  const size_t off = (size_t)(b * 2048 + t0 + tt) * 2048 + h * 128 + v4;
                  const f32x4 gn = *(const f32x4*)(hg_norm_g + v4); const unsigned long long gsw = *(const GAS unsigned long long*)(GS + off);
                  const unsigned g01 = (unsigned)gsw, g23 = (unsigned)(gsw >> 32);
                  const float r0 = o.x * rs * gn.x * bflo(g01), r1 = o.y * rs * gn.y * bfhi(g01), r2 = o.z * rs * gn.z * bflo(g23), r3 = o.w * rs * gn.w * bfhi(g23);
                  *(GAS unsigned long long*)(OAB + (size_t)MTOK * 2048 + off) = (unsigned long long)pk2(r0, r1) | ((unsigned long long)pk2(r2, r3) << 32); }
                __syncthreads();
            }
        }
        if (BOTH(4)) GRID_BAR();
    }
    if (IN(5)) {
        pg8::Gemm g{OAB, Wt_ab, 2 * MTOK, 8192, 2048}; pg8::DualOrder S; S.S.init(MTOK, 4096, F.G, (int)blockIdx.x);
        pg8::EpiMerge E{GA, GB, MERGED};
        pg8::gemm_phase<pg8::EpiMerge, pg8::DualOrder, true, true>(F.lds + RING_OFF, g, S, E);
        if (BOTH(5)) GRID_BAR();
    }
    if (IN(6)) {
        pg8::Gemm g{MERGED, Wt_out, MTOK, 4096, 4096}; pg8::StaticOrder S; S.init(MTOK, 4096, F.G, (int)blockIdx.x);
        pg8::EpiMix E{x, ST, ln_in_g, ln_in_b, R, ALPHA};
        pg8::gemm_phase<pg8::EpiMix, pg8::StaticOrder, true, true>(F.lds + RING_OFF, g, S, E);
        if (BOTH(6)) GRID_BAR();
    }
    if (IN(7)) {
        for (int m = gw; m < MTOK; m += NGW) ln_row<true, true, false>(R + (size_t)m * DM, ln1_g, ln1_b, R + (size_t)m * DM, HB + (size_t)m * DM, nullptr, F.lane);
        if (BOTH(7)) GRID_BAR();
    }
    if (IN(8)) {
        pg8::Gemm g{HB, Wt_gu, MTOK, 2 * DFF, DM}; pg8::StaticOrder S; S.init(MTOK, 2 * DFF, F.G, (int)blockIdx.x);
        pg8::EpiSwiglu E{ACT};
        pg8::gemm_phase<pg8::EpiSwiglu, pg8::StaticOrder, true, true>(F.lds + RING_OFF, g, S, E);
        if (BOTH(8)) GRID_BAR();
    }
    if (IN(9)) {
        pg8::Gemm g{ACT, Wt_down, MTOK, 4096, DFF}; pg8::StaticOrder S; S.init(MTOK, 4096, F.G, (int)blockIdx.x);
        pg8::EpiDown E{R, out, ALPHA};
        pg8::gemm_phase<pg8::EpiDown, pg8::StaticOrder, true, true>(F.lds + RING_OFF, g, S, E);
        if (BOTH(9)) GRID_BAR();
    }
    if (IN(10)) {
        for (int m = gw; m < MTOK; m += NGW) ln_row<true, false, false>(out + (size_t)m * DM, ln2_g, ln2_b, out + (size_t)m * DM, nullptr, nullptr, F.lane);
    }
#undef IN
#undef BOTH
}

extern "C" void kernel_launch(void* const* d_in, const int* in_sizes, int n_in, void* d_out, int out_size, void* d_ws, size_t ws_size, hipStream_t stream) {
    static int grid = 0;
    if (grid == 0) {
        if (n_in != 21 || out_size != MTOK * DM || ws_size < WS_END) { fprintf(stderr, "kernel_launch: unexpected shapes (n_in %d, out %d, ws %zu, need %zu)\n", n_in, out_size, ws_size, (size_t)WS_END); grid = -1; return; }
        int dev = 0, cus = 0, per_cu = 0;
        if (hipGetDevice(&dev) != hipSuccess || hipDeviceGetAttribute(&cus, hipDeviceAttributeMultiprocessorCount, dev) != hipSuccess) { grid = -1; return; }
        if (hipFuncSetAttribute((const void*)mega_fwd, hipFuncAttributeMaxDynamicSharedMemorySize, LDS_BYTES) != hipSuccess) { fprintf(stderr, "kernel_launch: hipFuncSetAttribute failed\n"); grid = -1; return; }
        if (hipOccupancyMaxActiveBlocksPerMultiprocessor(&per_cu, (const void*)mega_fwd, NWAVES * 64, LDS_BYTES) != hipSuccess || per_cu < 1)
            fprintf(stderr, "kernel_launch: note: occupancy query reports %d workgroups per CU\n", per_cu);
        (void)hipGetLastError();
        grid = cus;
    }
    if (grid < 0) return;
    if (hipMemsetAsync((char*)d_ws + WS_CTL, 0, CTL_ZERO_BYTES, stream) != hipSuccess) return;
    Args a{};
    for (int i = 0; i < 21; ++i) a.in[i] = d_in[i];
    a.out = (float*)d_out; a.ws = (unsigned char*)d_ws;
#if MK_ONE_LAUNCH
    a.ph_lo = 0; a.ph_hi = NPHASE;
    hipLaunchKernelGGL(mega_fwd, dim3(grid), dim3(NWAVES * 64), LDS_BYTES, stream, a);
#else
    for (int p = 0; p < NPHASE; ++p) { a.ph_lo = p; a.ph_hi = p + 1; hipLaunchKernelGGL(mega_fwd, dim3(grid), dim3(NWAVES * 64), LDS_BYTES, stream, a); }
#endif
}
```

```cpp
#include <hip/hip_runtime.h>
#include <cstdio>
#include <cstdint>
namespace pg8 {
#define PG8_LAS __attribute__((address_space(3)))
typedef unsigned short bf16_t;
typedef short bf16x8 __attribute__((ext_vector_type(8)));
typedef float f32x4 __attribute__((ext_vector_type(4)));
typedef unsigned u32x4 __attribute__((ext_vector_type(4)));
constexpr int BM = 256, BK = 64, HALF = 128, HTB = HALF * BK * 2  , STAGE_BYTES = 8 * HTB, NXCD = 8, WGM = 8;

__host__ __device__ __forceinline__ int lds_byte(int r, int c) { const int st = (r >> 4) * 2 + (c >> 5), rr = r & 15, cc = c & 31, ob = rr * 64 + cc * 2; return st * 1024 + (ob ^ (((ob >> 9) & 1) << 5)); }
__host__ __device__ __forceinline__ void stage_rc(int b, int& R, int& C) { const int st = b / 1024, sb = b % 1024, swz = sb ^ (((sb >> 9) & 1) << 5); R = (st >> 1) * 16 + swz / 64; C = (st & 1) * 32 + (swz % 64) / 2; }
__host__ __device__ __forceinline__ int perm32(int rho) { const int n = rho >> 4, i = rho & 15; return 8 * (i >> 2) + 4 * n + (i & 3); }

struct Unit { int pm, pn; };
struct Gemm { const bf16_t* A; const bf16_t* Bt; int M, N, K; };

struct StaticOrder {
    int nM, nN, nwg, G, c;
    __host__ __device__ void init(int M, int N, int G_, int c_) { nM = M / BM; nN = N / BM; nwg = nM * nN; G = G_; c = c_; }
    __host__ __device__ bool next(int i, Unit& u) const {
        const long L = (long)i * G + c; if (L >= nwg) return false;
        int wgid = (int)L; { const int q = nwg / NXCD, r = nwg % NXCD, xcd = wgid % NXCD, off = wgid / NXCD; wgid = (xcd < r ? xcd * (q + 1) : r * (q + 1) + (xcd - r) * q) + off; }
        const int nig = WGM * nN, gid = wgid / nig, fm = gid * WGM, gsz = (nM - fm) < WGM ? (nM - fm) : WGM;
        u.pm = fm + ((wgid % nig) % gsz); u.pn = (wgid % nig) / gsz; return true;
    }
    __device__ __forceinline__ void a_ready(const Unit&) const {}
    __device__ __forceinline__ void done(const Unit&) const {}
};

__device__ __forceinline__ unsigned cvt_pk_bf16(float lo, float hi) { unsigned r; asm volatile("v_cvt_pk_bf16_f32 %0, %1, %2" : "=v"(r) : "v"(lo), "v"(hi)); return r; }
typedef float f32x2 __attribute__((ext_vector_type(2)));
__device__ __forceinline__ f32x2 gelu_pk(f32x2 v) {
    const f32x2 av = __builtin_elementwise_abs(v), d = av * 0.2316418882f + 1.0f;
    f32x2 t; t.x = __builtin_amdgcn_rcpf(d.x); t.y = __builtin_amdgcn_rcpf(d.y);
    f32x2 q = t * 0.5307027145f + (-0.7265760135f); q = q * t + 0.7107068705f; q = q * t + (-0.142248368f); q = q * t + 0.127414796f; q = q * t;
    const f32x2 s = (v * v) * (-0.72134752044f);
    f32x2 e; e.x = __builtin_amdgcn_exp2f(s.x); e.y = __builtin_amdgcn_exp2f(s.y);
    const f32x2 m = v * (q * e), r = v - m;
    f32x2 o; o.x = v.x < 0.f ? m.x : r.x; o.y = v.y < 0.f ? m.y : r.y; return o;
}

template <class Epi, class Sched, bool ALIGN_EPI = false, bool SP2 = false>
__device__ __forceinline__ void gemm_phase(PG8_LAS unsigned char* lds, const Gemm g, const Sched& S, const Epi& E) {
    const int tid = threadIdx.x, wid = __builtin_amdgcn_readfirstlane(tid >> 6), lane = tid & 63, wr = wid >> 2, wc = wid & 3, fr = lane & 15, fq = lane >> 4;
    const int K = g.K, nt = K / BK;
    unsigned voffA[2], voffB[2];
#pragma unroll
    for (int i = 0; i < 2; ++i) { int R, C; stage_rc(tid * 16 + i * 8192, R, C); const int Rb = Epi::PERM ? ((R & ~31) + perm32(R & 31)) : R;
        voffA[i] = (unsigned)(R * K + C) * 2u; voffB[i] = (unsigned)(Rb * K + C) * 2u; }
    const size_t kstep = (size_t)(BK * 2);
    const size_t hstep = (size_t)HALF * K * 2;
    const size_t tstep = 2 * hstep;
    const unsigned ldsw = (unsigned)wid * 1024u;
    const int aoff = lds_byte(wr * 64 + fr, fq * 8), boff = lds_byte(wc * 32 + fr, fq * 8);
#define PG8_SA(b, h) (((b) * 2 + (h)) * HTB)
#define PG8_SB(b, h) ((4 + (b) * 2 + (h)) * HTB)
#define PG8_STAGE(bufoff, gbase, voff) do { _Pragma("unroll") for (int _i = 0; _i < 2; ++_i) \
        __builtin_amdgcn_global_load_lds((const unsigned*)((const char*)(gbase) + (voff)[_i]), (PG8_LAS unsigned*)(lds + (bufoff) + ldsw + _i * 8192), 16, 0, 0); } while (0)
#define PG8_LDA(dst, b, h) do { _Pragma("unroll") for (int m = 0; m < 4; ++m) _Pragma("unroll") for (int k = 0; k < 2; ++k) dst[m][k] = *(const PG8_LAS bf16x8*)(lds + PG8_SA(b, h) + aoff + m * 2048 + k * 1024); } while (0)
#define PG8_LDB(dst, b, h) do { _Pragma("unroll") for (int n = 0; n < 2; ++n) _Pragma("unroll") for (int k = 0; k < 2; ++k) dst[n][k] = *(const PG8_LAS bf16x8*)(lds + PG8_SB(b, h) + boff + n * 2048 + k * 1024); } while (0)
#define PG8_MMA(ai, bj, At, Bt) do { __builtin_amdgcn_s_setprio(1); _Pragma("unroll") for (int m = 0; m < 4; ++m) _Pragma("unroll") for (int n = 0; n < 2; ++n) _Pragma("unroll") for (int k = 0; k < 2; ++k) \
        acc[ai][bj][m][n] = __builtin_amdgcn_mfma_f32_16x16x32_bf16(Bt[n][k], At[m][k], acc[ai][bj][m][n], 0, 0, 0); __builtin_amdgcn_s_setprio(0); } while (0)
#define PG8_WAIT_V(n) asm volatile("s_waitcnt vmcnt(" #n ")" ::: "memory")
#define PG8_WAIT_L(n) asm volatile("s_waitcnt lgkmcnt(" #n ")" ::: "memory")
#define PG8_BAR __builtin_amdgcn_s_barrier()
#define PG8_SCHED __builtin_amdgcn_sched_barrier(0)
    Unit cur, nxt; int ui = 0;
    if (!S.next(0, cur)) return;
    f32x4 acc[2][2][4][2];
#pragma unroll
    for (int a = 0; a < 2; ++a)
#pragma unroll
        for (int b = 0; b < 2; ++b)
#pragma unroll
            for (int m = 0; m < 4; ++m)
#pragma unroll
                for (int n = 0; n < 2; ++n) acc[a][b][m][n] = (f32x4){0.f, 0.f, 0.f, 0.f};
    bf16x8 At[4][2], B0[2][2], B1[2][2];
    const char* cA = (const char*)g.A + (size_t)cur.pm * tstep; const char* cB = (const char*)g.Bt + (size_t)cur.pn * tstep;
    S.a_ready(cur);
    if constexpr (SP2) {
        PG8_STAGE(PG8_SB(0, 0), cB, voffB); PG8_STAGE(PG8_SB(0, 1), cB + hstep, voffB); PG8_STAGE(PG8_SA(0, 0), cA, voffA); PG8_STAGE(PG8_SA(0, 1), cA + hstep, voffA);
        if (wr == 1) PG8_BAR;
        PG8_WAIT_V(2); PG8_BAR;
        PG8_STAGE(PG8_SB(1, 0), cB + kstep, voffB); PG8_STAGE(PG8_SA(1, 0), cA + kstep, voffA); PG8_STAGE(PG8_SB(1, 1), cB + hstep + kstep, voffB);
        PG8_WAIT_V(6); PG8_BAR;
    } else {
        PG8_STAGE(PG8_SB(0, 0), cB, voffB); PG8_STAGE(PG8_SA(0, 0), cA, voffA); PG8_STAGE(PG8_SB(0, 1), cB + hstep, voffB); PG8_STAGE(PG8_SA(0, 1), cA + hstep, voffA);
        if (wr == 1) PG8_BAR;
        PG8_WAIT_V(4); PG8_BAR;
        PG8_STAGE(PG8_SB(1, 0), cB + kstep, voffB); PG8_STAGE(PG8_SA(1, 0), cA + kstep, voffA); PG8_STAGE(PG8_SB(1, 1), cB + hstep + kstep, voffB);
        PG8_WAIT_V(6); PG8_BAR;
    }
    for (;;) {
        const bool has_next = S.next(ui + 1, nxt);
        const char* nA = has_next ? (const char*)g.A + (size_t)nxt.pm * tstep : cA; const char* nB = has_next ? (const char*)g.Bt + (size_t)nxt.pn * tstep : cB;
        for (int t = 0; t < nt; t += 2) {
            const bool last = (t == nt - 2);
            const char* a1 = cA + (size_t)(t + 1) * kstep;
            const char* a2 = last ? nA : cA + (size_t)(t + 2) * kstep; const char* b2 = last ? nB : cB + (size_t)(t + 2) * kstep;
            const char* a3 = a2 + kstep; const char* b3 = b2 + kstep;
            if (last && has_next) S.a_ready(nxt);
            if constexpr (SP2) {
            PG8_LDB(B0, 0, 0); PG8_LDB(B1, 0, 1); PG8_SCHED; PG8_LDA(At, 0, 0); PG8_STAGE(PG8_SA(1, 1), a1 + hstep, voffA);
            PG8_WAIT_V(8); PG8_WAIT_L(0); PG8_BAR; PG8_MMA(0, 0, At, B0); PG8_MMA(0, 1, At, B1); PG8_BAR; PG8_SCHED;
            PG8_LDA(At, 0, 1); PG8_STAGE(PG8_SB(0, 0), b2, voffB); PG8_STAGE(PG8_SB(0, 1), b2 + hstep, voffB); PG8_STAGE(PG8_SA(0, 0), a2, voffA);
            PG8_WAIT_V(8); PG8_WAIT_L(0); PG8_BAR; PG8_MMA(1, 0, At, B0); PG8_MMA(1, 1, At, B1); PG8_BAR; PG8_SCHED;
            PG8_LDB(B0, 1, 0); PG8_LDB(B1, 1, 1); PG8_SCHED; PG8_LDA(At, 1, 0); PG8_STAGE(PG8_SA(0, 1), a2 + hstep, voffA);
            PG8_WAIT_V(8); PG8_WAIT_L(0); PG8_BAR; PG8_MMA(0, 0, At, B0); PG8_MMA(0, 1, At, B1); PG8_BAR; PG8_SCHED;
            PG8_LDA(At, 1, 1); PG8_STAGE(PG8_SB(1, 0), b3, voffB); PG8_STAGE(PG8_SB(1, 1), b3 + hstep, voffB); PG8_STAGE(PG8_SA(1, 0), a3, voffA);
            PG8_WAIT_V(8); PG8_WAIT_L(0); PG8_BAR; PG8_MMA(1, 0, At, B0); PG8_MMA(1, 1, At, B1); PG8_BAR; PG8_SCHED;
            } else {
            PG8_LDB(B0, 0, 0); PG8_SCHED; PG8_LDA(At, 0, 0); PG8_STAGE(PG8_SA(1, 1), a1 + hstep, voffA);
            PG8_WAIT_L(8); PG8_BAR; PG8_WAIT_L(0); PG8_MMA(0, 0, At, B0); PG8_BAR; PG8_SCHED;
            PG8_LDB(B1, 0, 1); PG8_STAGE(PG8_SB(0, 0), b2, voffB);
            PG8_BAR; PG8_WAIT_L(0); PG8_MMA(0, 1, At, B1); PG8_BAR;
            PG8_LDA(At, 0, 1); PG8_STAGE(PG8_SA(0, 0), a2, voffA);
            PG8_BAR; PG8_WAIT_L(0); PG8_MMA(1, 0, At, B0); PG8_BAR; PG8_SCHED;
            PG8_STAGE(PG8_SB(0, 1), b2 + hstep, voffB);
            PG8_WAIT_V(6); PG8_BAR; PG8_MMA(1, 1, At, B1); PG8_BAR;
            PG8_LDB(B0, 1, 0); PG8_SCHED; PG8_LDA(At, 1, 0); PG8_STAGE(PG8_SA(0, 1), a2 + hstep, voffA);
            PG8_WAIT_L(8); PG8_BAR; PG8_WAIT_L(0); PG8_MMA(0, 0, At, B0); PG8_BAR; PG8_SCHED;
            PG8_LDB(B1, 1, 1); PG8_STAGE(PG8_SB(1, 0), b3, voffB);
            PG8_BAR; PG8_WAIT_L(0); PG8_MMA(0, 1, At, B1); PG8_BAR;
            PG8_LDA(At, 1, 1); PG8_STAGE(PG8_SA(1, 0), a3, voffA);
            PG8_BAR; PG8_WAIT_L(0); PG8_MMA(1, 0, At, B0); PG8_BAR; PG8_SCHED;
            PG8_STAGE(PG8_SB(1, 1), b3 + hstep, voffB);
            PG8_WAIT_V(6); PG8_BAR; PG8_MMA(1, 1, At, B1); PG8_BAR;
            }
        }
        if constexpr (ALIGN_EPI) { if (wr == 0) PG8_BAR; }
        if constexpr (!Epi::AFTER_DRAIN) { E(acc, cur, wr, wc, fr, fq); S.done(cur); }
        if (!has_next) break;
        if (!E.keep(cur)) {
#pragma unroll
        for (int a = 0; a < 2; ++a)
#pragma unroll
            for (int b = 0; b < 2; ++b)
#pragma unroll
                for (int m = 0; m < 4; ++m)
#pragma unroll
                    for (int n = 0; n < 2; ++n) acc[a][b][m][n] = (f32x4){0.f, 0.f, 0.f, 0.f};
        }
        cur = nxt; cA = nA; cB = nB; ++ui;
        if constexpr (ALIGN_EPI) { if (wr == 1) PG8_BAR; }
    }
    PG8_WAIT_V(0);
    if constexpr (!ALIGN_EPI) { if (wr == 0) PG8_BAR; }
    PG8_BAR;
    if constexpr (Epi::AFTER_DRAIN) { E.fused(acc, cur, wr, wc, fr, fq, lds, wid, lane); S.done(cur); }
#undef PG8_SA
#undef PG8_SB
#undef PG8_STAGE
#undef PG8_LDA
#undef PG8_LDB
#undef PG8_MMA
#undef PG8_WAIT_V
#undef PG8_WAIT_L
#undef PG8_BAR
#undef PG8_SCHED
}
}

namespace pg8 {
__device__ __forceinline__ float bf2f(unsigned short h) { return __uint_as_float(((unsigned)h) << 16); }
__device__ __forceinline__ float bflo(unsigned w) { return __uint_as_float(w << 16); }
__device__ __forceinline__ float bfhi(unsigned w) { return __uint_as_float(w & 0xffff0000u); }
__device__ __forceinline__ float sigm(float x) { return __builtin_amdgcn_rcpf(1.f + __builtin_amdgcn_exp2f(-1.4426950408889634f * x)); }
__device__ __forceinline__ u32x4 pack8(f32x4 a, f32x4 b) { u32x4 w; w.x = cvt_pk_bf16(a[0], a[1]); w.y = cvt_pk_bf16(a[2], a[3]); w.z = cvt_pk_bf16(b[0], b[1]); w.w = cvt_pk_bf16(b[2], b[3]); return w; }

struct EpiProj {
    static constexpr bool PERM = true, AFTER_DRAIN = false;
    float* CF; bf16_t* QH; float* G; bf16_t* HI; bf16_t* GS; bf16_t* GA; bf16_t* GB; const float* hg_lb;
    __device__ __forceinline__ bool keep(const Unit&) const { return false; }
    __device__ __forceinline__ void operator()(f32x4 (&acc)[2][2][4][2], const Unit& u, int wr, int wc, int fr, int fq) const {
        const int pn = u.pn; int mode, ct, ldc; float* pf = nullptr; bf16_t* ph = nullptr;
        if (pn < 7) { mode = 0; ct = pn; ldc = 1792; pf = CF; }
        else if (pn < 15) { mode = 1; ct = pn - 7; ldc = 2048; ph = QH; }
        else if (pn < 23) { mode = 2; ct = pn - 15; ldc = 2048; pf = G; }
        else if (pn < 31) { mode = 3; ct = pn - 23; ldc = 2048; ph = HI; }
        else if (pn < 39) { mode = 1; ct = pn - 31; ldc = 2048; ph = GS; }
        else if (pn < 55) { mode = 4; ct = pn - 39; ldc = 4096; ph = GA; }
        else { mode = 4; ct = pn - 55; ldc = 4096; ph = GB; }
        const int row0 = u.pm * BM + wr * 64 + fr, col0 = ct * BM + wc * 32 + 8 * fq;
        if (mode == 0) {
#pragma unroll
            for (int ai = 0; ai < 2; ++ai)
#pragma unroll
                for (int m = 0; m < 4; ++m) { float* rowp = pf + (size_t)(row0 + ai * HALF + m * 16) * ldc + col0;
#pragma unroll
                    for (int bj = 0; bj < 2; ++bj) { *(f32x4*)(rowp + bj * HALF) = acc[ai][bj][m][0]; *(f32x4*)(rowp + bj * HALF + 4) = acc[ai][bj][m][1]; } }
        } else if (mode == 2) {
#pragma unroll
            for (int bj = 0; bj < 2; ++bj) {
                f32x4 lb[2];
#pragma unroll
                for (int n = 0; n < 2; ++n) { const f32x4 l0 = *(const f32x4*)(hg_lb + col0 + bj * HALF + 4 * n), l1 = *(const f32x4*)(hg_lb + 2048 + col0 + bj * HALF + 4 * n);
#pragma unroll
                    for (int i = 0; i < 4; ++i) lb[n][i] = sigm(l0[i] - l1[i]); }
#pragma unroll
                for (int ai = 0; ai < 2; ++ai)
#pragma unroll
                    for (int m = 0; m < 4; ++m) { float* rowp = pf + (size_t)(row0 + ai * HALF + m * 16) * ldc + col0 + bj * HALF;
#pragma unroll
                        for (int n = 0; n < 2; ++n) { f32x4 v = acc[ai][bj][m][n], o;
#pragma unroll
                            for (int i = 0; i < 4; ++i) { const float f = lb[n][i] + (1.f - lb[n][i]) * sigm(v[i]); o[i] = __builtin_amdgcn_logf(f) * 0.6931471805599453f; }
                            *(f32x4*)(rowp + 4 * n) = o; } }
            }
        } else {
#pragma unroll
            for (int ai = 0; ai < 2; ++ai)
#pragma unroll
                for (int m = 0; m < 4; ++m) { bf16_t* rowp = ph + (size_t)(row0 + ai * HALF + m * 16) * ldc + col0;
#pragma unroll
                    for (int bj = 0; bj < 2; ++bj) { f32x4 v0 = acc[ai][bj][m][0], v1 = acc[ai][bj][m][1];
                        if (mode == 1) {
#pragma unroll
                            for (int i = 0; i < 4; ++i) { v0[i] = v0[i] * sigm(v0[i]); v1[i] = v1[i] * sigm(v1[i]); } }
                        else if (mode == 4) {
#pragma unroll
                            for (int i = 0; i < 4; ++i) { v0[i] = sigm(v0[i]); v1[i] = sigm(v1[i]); } }
                        *(u32x4*)(rowp + bj * HALF) = pack8(v0, v1); } }
        }
    }
};
struct EpiPlain {
    static constexpr bool PERM = true, AFTER_DRAIN = false;
    bf16_t* O; int ldc;
    __device__ __forceinline__ bool keep(const Unit&) const { return false; }
    __device__ __forceinline__ void operator()(f32x4 (&acc)[2][2][4][2], const Unit& u, int wr, int wc, int fr, int fq) const {
        const int row0 = u.pm * BM + wr * 64 + fr, col0 = u.pn * BM + wc * 32 + 8 * fq;
#pragma unroll
        for (int ai = 0; ai < 2; ++ai)
#pragma unroll
            for (int m = 0; m < 4; ++m) { bf16_t* rowp = O + (size_t)(row0 + ai * HALF + m * 16) * ldc + col0;
#pragma unroll
                for (int bj = 0; bj < 2; ++bj) *(u32x4*)(rowp + bj * HALF) = pack8(acc[ai][bj][m][0], acc[ai][bj][m][1]); }
    }
};
struct EpiQ {
    static constexpr bool PERM = true, AFTER_DRAIN = false;
    bf16_t* Q; const float* CS;
    __device__ __forceinline__ bool keep(const Unit&) const { return false; }
    __device__ __forceinline__ void operator()(f32x4 (&acc)[2][2][4][2], const Unit& u, int wr, int wc, int fr, int fq) const {
        const int row0 = u.pm * BM + wr * 64 + fr;
#pragma unroll
        for (int bj = 0; bj < 2; ++bj) {
            const int gi = u.pn * 8 + bj * 4 + wc, part = gi % 6, col0 = gi * 32 + 8 * fq;
            if (part < 4) {
#pragma unroll
                for (int ai = 0; ai < 2; ++ai)
#pragma unroll
                    for (int m = 0; m < 4; ++m) *(u32x4*)(Q + (size_t)(row0 + ai * HALF + m * 16) * 3072 + col0) = pack8(acc[ai][bj][m][0], acc[ai][bj][m][1]);
            } else {
                const int i0 = (part - 4) * 16 + 4 * fq;
#pragma unroll
                for (int ai = 0; ai < 2; ++ai)
#pragma unroll
                    for (int m = 0; m < 4; ++m) { const int row = row0 + ai * HALF + m * 16;
                        const f32x4 c = *(const f32x4*)(CS + (size_t)row * 64 + i0), s = *(const f32x4*)(CS + (size_t)row * 64 + 32 + i0);
                        const f32x4 v0 = acc[ai][bj][m][0], v1 = acc[ai][bj][m][1]; f32x4 o0, o1;
                        o0[0] = v0[0] * c[0] - v0[1] * s[0]; o0[1] = v0[0] * s[0] + v0[1] * c[0]; o0[2] = v0[2] * c[1] - v0[3] * s[1]; o0[3] = v0[2] * s[1] + v0[3] * c[1];
                        o1[0] = v1[0] * c[2] - v1[1] * s[2]; o1[1] = v1[0] * s[2] + v1[1] * c[2]; o1[2] = v1[2] * c[3] - v1[3] * s[3]; o1[3] = v1[2] * s[3] + v1[3] * c[3];
                        *(u32x4*)(Q + (size_t)row * 3072 + col0) = pack8(o0, o1); }
            }
        }
    }
};
struct EpiMerge {
    static constexpr bool PERM = true, AFTER_DRAIN = false;
    const bf16_t* GA; const bf16_t* GB; bf16_t* O;
    __device__ __forceinline__ bool keep(const Unit& u) const { return u.pm < 32; }
    __device__ __forceinline__ void operator()(f32x4 (&acc)[2][2][4][2], const Unit& u, int wr, int wc, int fr, int fq) const {
        const bool second = u.pm >= 32;
        const int row0 = (u.pm & 31) * BM + wr * 64 + fr, col0 = (u.pn & 15) * BM + wc * 32 + 8 * fq;
#pragma unroll
        for (int ai = 0; ai < 2; ++ai)
#pragma unroll
            for (int m = 0; m < 4; ++m) { const size_t off = (size_t)(row0 + ai * HALF + m * 16) * 4096 + col0;
#pragma unroll
                for (int bj = 0; bj < 2; ++bj) {
                    const u32x4 gb = *(const u32x4*)(GB + off + bj * HALF);
                    f32x4 b0, b1; b0[0] = bflo(gb.x); b0[1] = bfhi(gb.x); b0[2] = bflo(gb.y); b0[3] = bfhi(gb.y); b1[0] = bflo(gb.z); b1[1] = bfhi(gb.z); b1[2] = bflo(gb.w); b1[3] = bfhi(gb.w);
#pragma unroll
                    for (int i = 0; i < 4; ++i) { b0[i] = fmaxf(b0[i], 1e-30f); b1[i] = fmaxf(b1[i], 1e-30f); }
                    if (!second) {
                        const u32x4 ga = *(const u32x4*)(GA + off + bj * HALF);
                        f32x4 a0, a1; a0[0] = bflo(ga.x); a0[1] = bfhi(ga.x); a0[2] = bflo(ga.y); a0[3] = bfhi(ga.y); a1[0] = bflo(ga.z); a1[1] = bfhi(ga.z); a1[2] = bflo(ga.w); a1[3] = bfhi(ga.w);
#pragma unroll
                        for (int i = 0; i < 4; ++i) { acc[ai][bj][m][0][i] *= a0[i] * __builtin_amdgcn_rcpf(b0[i]); acc[ai][bj][m][1][i] *= a1[i] * __builtin_amdgcn_rcpf(b1[i]); }
                    } else {
                        *(u32x4*)(O + off + bj * HALF) = pack8(acc[ai][bj][m][0] * b0, acc[ai][bj][m][1] * b1);
                    }
                } }
    }
};
struct DualOrder {
    StaticOrder S;
    __device__ __forceinline__ bool next(int i, Unit& u) const { if (!S.next(i >> 1, u)) return false; if (i & 1) { u.pm += 32; u.pn += 16; } return true; }
    __device__ __forceinline__ void a_ready(const Unit&) const {}
    __device__ __forceinline__ void done(const Unit&) const {}
};
struct EpiMix {
    static constexpr bool PERM = false, AFTER_DRAIN = false;
    const float* X; const float* ST; const float* g; const float* b; float* Y; float alpha;
    __device__ __forceinline__ bool keep(const Unit&) const { return false; }
    __device__ __forceinline__ void operator()(f32x4 (&acc)[2][2][4][2], const Unit& u, int wr, int wc, int fr, int fq) const {
        const int row0 = u.pm * BM + wr * 64 + fr, col0 = u.pn * BM + wc * 32 + 4 * fq;
#pragma unroll
        for (int ai = 0; ai < 2; ++ai)
#pragma unroll
            for (int m = 0; m < 4; ++m) { const int row = row0 + ai * HALF + m * 16; const float mu = ST[2 * row], rs = ST[2 * row + 1]; const size_t off = (size_t)row * 4096 + col0;
#pragma unroll
                for (int bj = 0; bj < 2; ++bj)
#pragma unroll
                    for (int n = 0; n < 2; ++n) { const int cc = bj * HALF + n * 16; const f32x4 xv = *(const f32x4*)(X + off + cc), gv = *(const f32x4*)(g + col0 + cc), bv = *(const f32x4*)(b + col0 + cc);
                        *(f32x4*)(Y + off + cc) = ((xv - mu) * rs * gv + bv) * alpha + acc[ai][bj][m][n]; } }
    }
};
struct EpiSwiglu {
    static constexpr bool PERM = true, AFTER_DRAIN = false;
    bf16_t* O;
    __device__ __forceinline__ bool keep(const Unit&) const { return false; }
    __device__ __forceinline__ void operator()(f32x4 (&acc)[2][2][4][2], const Unit& u, int wr, int wc, int fr, int fq) const {
        const int row0 = u.pm * BM + wr * 64 + fr, col0 = u.pn * HALF + wc * 32 + 8 * fq;
#pragma unroll
        for (int ai = 0; ai < 2; ++ai)
#pragma unroll
            for (int m = 0; m < 4; ++m) { f32x4 o0, o1;
#pragma unroll
                for (int i = 0; i < 4; ++i) { const float g0 = acc[ai][0][m][0][i], g1 = acc[ai][0][m][1][i]; o0[i] = g0 * sigm(g0) * acc[ai][1][m][0][i]; o1[i] = g1 * sigm(g1) * acc[ai][1][m][1][i]; }
                *(u32x4*)(O + (size_t)(row0 + ai * HALF + m * 16) * 11008 + col0) = pack8(o0, o1); }
    }
};
struct EpiDown {
    static constexpr bool PERM = false, AFTER_DRAIN = false;
    const float* H1; float* Z; float alpha;
    __device__ __forceinline__ bool keep(const Unit&) const { return false; }
    __device__ __forceinline__ void operator()(f32x4 (&acc)[2][2][4][2], const Unit& u, int wr, int wc, int fr, int fq) const {
        const int row0 = u.pm * BM + wr * 64 + fr, col0 = u.pn * BM + wc * 32 + 4 * fq;
#pragma unroll
        for (int ai = 0; ai < 2; ++ai)
#pragma unroll
            for (int m = 0; m < 4; ++m) { const size_t off = (size_t)(row0 + ai * HALF + m * 16) * 4096 + col0;
#pragma unroll
                for (int bj = 0; bj < 2; ++bj)
#pragma unroll
                    for (int n = 0; n < 2; ++n) { const int cc = bj * HALF + n * 16; *(f32x4*)(Z + off + cc) = *(const f32x4*)(H1 + off + cc) * alpha + acc[ai][bj][m][n]; } }
    }
};
}

#ifndef MK_ONE_LAUNCH
#define MK_ONE_LAUNCH 1
#endif
constexpr int NWAVES = 8;
constexpr int NPHASE = 11;
constexpr int MTOK = 8192, DM = 4096, DFF = 11008, NPROJ = 18176;
constexpr float LN_EPS = 1e-5f;
constexpr float ALPHA = 1.189207115002721f;
constexpr float QSCALE = 0.07216878364870322f * 1.4426950408889634f;
constexpr size_t MiB = 1u << 20;
constexpr size_t WS_CTL = 0, CTL_ZERO_BYTES = 1 * MiB;
constexpr size_t WS_CS = 1 * MiB;
constexpr size_t WS_ST = 3 * MiB;
constexpr size_t WS_WIN = 8 * MiB;
constexpr size_t WS_Q = 8 * MiB;
constexpr size_t WS_KV = 56 * MiB;
constexpr size_t WS_CQN = 120 * MiB;
constexpr size_t WS_CKVN = 136 * MiB;
constexpr size_t WS_KROPE = 144 * MiB;
constexpr size_t WS_WUQ = 150 * MiB, WS_WUKV = 156 * MiB, WS_WAB = 160 * MiB, WS_WOUT = 192 * MiB, WS_WGU = 224 * MiB, WS_WDOWN = 396 * MiB;
constexpr size_t WS_HB = 482 * MiB;
constexpr size_t WS_CF = 546 * MiB;
constexpr size_t WS_QH = 602 * MiB, WS_G = 634 * MiB, WS_HI = 698 * MiB, WS_GS = 730 * MiB, WS_GA = 762 * MiB, WS_GB = 826 * MiB;
constexpr size_t WS_R = 546 * MiB;
constexpr size_t WS_ACT = 674 * MiB;
constexpr size_t WS_OAB = 890 * MiB;
constexpr size_t WS_END = 954 * MiB;
static_assert(WS_WIN + (size_t)NPROJ * DM * 2 <= WS_WUQ && WS_KROPE + (size_t)MTOK * 64 * 2 <= WS_WUQ, "ws map 1");
static_assert(WS_WGU + (size_t)2 * DFF * DM * 2 <= WS_WDOWN && WS_WDOWN + (size_t)DFF * DM * 2 <= WS_HB, "ws map 2");
static_assert(WS_CF + (size_t)MTOK * 1792 * 4 <= WS_QH && WS_R + (size_t)MTOK * DM * 4 <= WS_ACT && WS_ACT + (size_t)MTOK * DFF * 2 <= WS_OAB, "ws map 3");
constexpr int CW_BAR = 4096;
constexpr int RING_OFF = 0, RING_BYTES = 131072;
constexpr int LDSCTL_OFF = RING_BYTES, MISC_OFF = LDSCTL_OFF + 320;
constexpr int LDS_BYTES = 147456;
#define GAS __attribute__((address_space(1)))
#define LAS __attribute__((address_space(3)))
typedef unsigned short bf16;
typedef unsigned v4u __attribute__((ext_vector_type(4)));
typedef float f32x4 __attribute__((ext_vector_type(4)));
typedef short bf16x8 __attribute__((ext_vector_type(8)));
typedef GAS unsigned gu32;
typedef GAS unsigned long long gu64;
#define RLX_AGENT __ATOMIC_RELAXED, __HIP_MEMORY_SCOPE_AGENT
#define LDS_WAIT() asm volatile("s_waitcnt lgkmcnt(0)" ::: "memory")
#define VM_WAIT() asm volatile("s_waitcnt vmcnt(0)" ::: "memory")
__device__ __forceinline__ unsigned long long rt() { return __builtin_amdgcn_s_memrealtime(); }
__device__ __forceinline__ unsigned f2bf(float f) { unsigned u = __builtin_bit_cast(unsigned, f); return (u + 0x7fffu + ((u >> 16) & 1u)) >> 16; }
__device__ __forceinline__ unsigned pk2(float lo, float hi) { return f2bf(lo) | (f2bf(hi) << 16); }

#define XB_TMO      128
#define XB_XCNT(j)  (256  + 64 * (j))
#define XB_XSUB(j)  (1280 + 64 * (j))
#define XB_XGEN(j)  (2304 + 64 * (j))
#define XB_TOP      3328
#define XB_TOPGEN   3392
#define XCD_BAR_WORDS 3456
#define XB_SPIN_CAP (1u << 18)

__device__ __forceinline__ unsigned xb_ld(unsigned* p)              { return __hip_atomic_load(p, __ATOMIC_RELAXED, __HIP_MEMORY_SCOPE_AGENT); }
__device__ __forceinline__ unsigned xb_add(unsigned* p, unsigned v) { return __hip_atomic_fetch_add(p, v, __ATOMIC_RELAXED, __HIP_MEMORY_SCOPE_AGENT); }
__device__ __forceinline__ unsigned xb_xcc_id() { return (unsigned)__builtin_amdgcn_s_getreg((3 << 11) | 20) & 0xFu; }
#define XB_SPIN(cond, bar) do { unsigned _sp = 0; while (cond) { __builtin_amdgcn_s_sleep(1); \
    if ((++_sp & 255u) == 0u) { if (xb_ld(&(bar)[XB_TMO])) break; if (_sp > XB_SPIN_CAP) { atomicAdd(&(bar)[XB_TMO], 1u); break; } } } } while (0)

struct XcdBarrier {
    unsigned* bar; unsigned x;
    volatile LAS unsigned* st;
};

__device__ __forceinline__ XcdBarrier xcd_barrier_post(unsigned* bar, volatile LAS unsigned* st) {
    XcdBarrier b; b.bar = bar; b.x = xb_xcc_id(); b.st = st;
    if (threadIdx.x == 0) (void)xb_add(&bar[XB_XCNT(b.x)], 1u);
    return b;
}
__device__ __forceinline__ void xcd_barrier_complete(unsigned* bar, unsigned x, unsigned& nloc, unsigned& nx) {
    const unsigned G = gridDim.x * gridDim.y * gridDim.z;
    unsigned sum, cnt, mine, sp = 0u;
    for (;;) {
        sum = 0u; cnt = 0u; mine = 0u;
#pragma unroll
        for (unsigned j = 0; j < 16; ++j) { const unsigned c = xb_ld(&bar[XB_XCNT(j)]); sum += c; cnt += (c > 0u) ? 1u : 0u; mine = (j == x) ? c : mine; }
        if (sum == G) break;
        __builtin_amdgcn_s_sleep(1);
        if ((++sp & 255u) == 0u) { if (xb_ld(&bar[XB_TMO])) break; if (sp > XB_SPIN_CAP) { atomicAdd(&bar[XB_TMO], 1u); break; } }
    }
    nloc = mine > 0u ? mine : 1u; nx = cnt > 0u ? cnt : 1u;
}

__device__ __forceinline__ void xcd_barrier(const XcdBarrier& b) {
    asm volatile("s_waitcnt vmcnt(0)" ::: "memory");
    __syncthreads();
    if (threadIdx.x == 0) {
        unsigned* bar = b.bar;
        __builtin_amdgcn_s_waitcnt(0);
        unsigned nloc = b.st[0], nx = b.st[1];
        if (nloc == 0u) { xcd_barrier_complete(bar, b.x, nloc, nx); b.st[0] = nloc; b.st[1] = nx; }
        const unsigned old = xb_add(&bar[XB_XSUB(b.x)], 1u);
        const unsigned gen = old / nloc;
        if (old + 1u == (gen + 1u) * nloc) {
            __builtin_amdgcn_fence(__ATOMIC_RELEASE, "agent");
            asm volatile("s_waitcnt vmcnt(0)" ::: "memory");
            const unsigned og = xb_add(&bar[XB_TOP], 1u);
            const unsigned tg = og / nx;
            if (og + 1u == (tg + 1u) * nx) xb_add(&bar[XB_TOPGEN], 1u);
            else XB_SPIN(xb_ld(&bar[XB_TOPGEN]) == tg, bar);
            __builtin_amdgcn_fence(__ATOMIC_ACQUIRE, "agent");
            xb_add(&bar[XB_XGEN(b.x)], 1u);
            asm volatile("s_waitcnt vmcnt(0)" ::: "memory");
        } else {
            XB_SPIN(xb_ld(&bar[XB_XGEN(b.x)]) == gen, bar);
            __builtin_amdgcn_fence(__ATOMIC_ACQUIRE, "agent");
            asm volatile("s_waitcnt vmcnt(0)" ::: "memory");
        }
    }
    __syncthreads();
}

namespace att {
typedef float f32x16 __attribute__((ext_vector_type(16)));
typedef short s16x4 __attribute__((ext_vector_type(4)));
typedef short bf16x8 __attribute__((ext_vector_type(8)));
typedef unsigned u32x4 __attribute__((ext_vector_type(4)));
typedef float f32x2_t __attribute__((ext_vector_type(2))); typedef __bf16 bf16x2_t __attribute__((ext_vector_type(2)));
constexpr int KP = 400, VP = 320, KBUF = 64 * KP, VBUF = 64 * VP, LDS_NEED = 2 * KBUF + 2 * VBUF;
__device__ __forceinline__ unsigned cvtpk(float lo, float hi) { f32x2_t v = {lo, hi}; bf16x2_t b = __builtin_convertvector(v, bf16x2_t); return __builtin_bit_cast(unsigned, b); }
__device__ __forceinline__ s16x4 vtr(const LAS unsigned char* p) { return __builtin_bit_cast(s16x4, __builtin_amdgcn_ds_read_tr16_b64_v4i16((LAS s16x4*)p)); }
__device__ __forceinline__ void attn_unit(LAS unsigned char* lds, const bf16* Q, const bf16* KV, const bf16* KROPE, bf16* OA, int b, int h, int qb, int tid) {
    const int lane = tid & 63, wid = __builtin_amdgcn_readfirstlane(tid >> 6), r32 = lane & 31, hh = lane >> 5;
    const size_t rowbase = (size_t)b * 2048;
    const int q0 = qb * 256 + wid * 32;
    bf16x8 qf[12];
    { const bf16* qrow = Q + (rowbase + q0 + r32) * 3072 + h * 192 + hh * 8;
#pragma unroll
      for (int d0 = 0; d0 < 12; ++d0) qf[d0] = *(const GAS bf16x8*)(qrow + d0 * 16); }
    const int NT = 4 * (qb + 1), myNT = 4 * qb + (wid >> 1) + 1;
    const GAS unsigned char* kvb = (const GAS unsigned char*)KV; const long krope_delta = (const unsigned char*)KROPE - (const unsigned char*)KV;
    unsigned ksrc[3], kstr[3]; int kdst[3];
#pragma unroll
    for (int i = 0; i < 3; ++i) { const int c = tid + 512 * i, row = c / 24, cc = c - row * 24;
        if (cc < 16) { ksrc[i] = (unsigned)(((rowbase + row) * 4096 + h * 256 + cc * 8) * 2); kstr[i] = 64u * 4096u * 2u; }
        else { ksrc[i] = (unsigned)(krope_delta + (long)((rowbase + row) * 64 + (cc - 16) * 8) * 2); kstr[i] = 64u * 64u * 2u; }
        kdst[i] = row * KP + cc * 16; }
    unsigned vsrc[2]; int vdst[2];
#pragma unroll
    for (int i = 0; i < 2; ++i) { const int c = tid + 512 * i, row = c >> 4, cc = c & 15; vsrc[i] = (unsigned)(((rowbase + row) * 4096 + h * 256 + 128 + cc * 8) * 2); vdst[i] = row * VP + cc * 16; }
    u32x4 kreg[3], vreg[2];
#define ATT_LOAD(t) do { _Pragma("unroll") for (int i = 0; i < 3; ++i) kreg[i] = *(const GAS u32x4*)(kvb + (ksrc[i] + (unsigned)(t) * kstr[i])); \
                         _Pragma("unroll") for (int i = 0; i < 2; ++i) vreg[i] = *(const GAS u32x4*)(kvb + (vsrc[i] + (unsigned)(t) * (64u * 4096u * 2u))); } while (0)
#define ATT_STORE(buf) do { _Pragma("unroll") for (int i = 0; i < 3; ++i) *(LAS u32x4*)(lds + (buf) * KBUF + kdst[i]) = kreg[i]; \
                            _Pragma("unroll") for (int i = 0; i < 2; ++i) *(LAS u32x4*)(lds + 2 * KBUF + (buf) * VBUF + vdst[i]) = vreg[i]; } while (0)
    __syncthreads();
    ATT_LOAD(0); ATT_STORE(0);
    __syncthreads();
    f32x16 o[4];
#pragma unroll
    for (int d = 0; d < 4; ++d)
#pragma unroll
        for (int r = 0; r < 16; ++r) o[d][r] = 0.f;
    float mrun = -1e30f, lrun = 0.f;
    const int koff = r32 * KP + hh * 16;
    const int voff = (4 * hh + ((lane & 15) >> 2)) * VP + ((lane >> 4) & 1) * 32 + (lane & 3) * 8;
    for (int t = 0; t < NT; ++t) {
        const int buf = t & 1;
        if (t + 1 < NT) ATT_LOAD(t + 1);
        if (t < myNT) {
            const LAS unsigned char* Kb = lds + buf * KBUF + koff; const LAS unsigned char* Vb = lds + 2 * KBUF + buf * VBUF + voff;
            f32x16 p0, p1;
#pragma unroll
            for (int r = 0; r < 16; ++r) { p0[r] = 0.f; p1[r] = 0.f; }
#pragma unroll
            for (int d0 = 0; d0 < 12; ++d0) {
                const bf16x8 a0 = *(const LAS bf16x8*)(Kb + d0 * 32), a1 = *(const LAS bf16x8*)(Kb + 32 * KP + d0 * 32);
                p0 = __builtin_amdgcn_mfma_f32_32x32x16_bf16(a0, qf[d0], p0, 0, 0, 0);
                p1 = __builtin_amdgcn_mfma_f32_32x32x16_bf16(a1, qf[d0], p1, 0, 0, 0);
                if ((d0 & 3) == 3) __builtin_amdgcn_sched_barrier(0);
            }
            float mt = fmaxf(p0[0], p1[0]);
#pragma unroll
            for (int r = 1; r < 16; ++r) mt = fmaxf(mt, fmaxf(p0[r], p1[r]));
            mt = fmaxf(mt, __shfl_xor(mt, 32));
            const float mn = fmaxf(mrun, mt), corr = __builtin_amdgcn_exp2f(mrun - mn); mrun = mn;
            float rs = 0.f;
#pragma unroll
            for (int r = 0; r < 16; ++r) { p0[r] = __builtin_amdgcn_exp2f(p0[r] - mn); p1[r] = __builtin_amdgcn_exp2f(p1[r] - mn); rs += p0[r] + p1[r]; }
            lrun = lrun * corr + rs;
#pragma unroll
            for (int d = 0; d < 4; ++d)
#pragma unroll
                for (int r = 0; r < 16; ++r) o[d][r] *= corr;
#pragma unroll
            for (int ks = 0; ks < 4; ++ks) {
                u32x4 pw;
                if (ks == 0) { pw.x = cvtpk(p0[0], p0[1]); pw.y = cvtpk(p0[2], p0[3]); pw.z = cvtpk(p0[4], p0[5]); pw.w = cvtpk(p0[6], p0[7]); }
                else if (ks == 1) { pw.x = cvtpk(p0[8], p0[9]); pw.y = cvtpk(p0[10], p0[11]); pw.z = cvtpk(p0[12], p0[13]); pw.w = cvtpk(p0[14], p0[15]); }
                else if (ks == 2) { pw.x = cvtpk(p1[0], p1[1]); pw.y = cvtpk(p1[2], p1[3]); pw.z = cvtpk(p1[4], p1[5]); pw.w = cvtpk(p1[6], p1[7]); }
                else { pw.x = cvtpk(p1[8], p1[9]); pw.y = cvtpk(p1[10], p1[11]); pw.z = cvtpk(p1[12], p1[13]); pw.w = cvtpk(p1[14], p1[15]); }
                const bf16x8 pf = __builtin_bit_cast(bf16x8, pw);
#pragma unroll
                for (int d = 0; d < 4; ++d) {
                    const s16x4 lo = vtr(Vb + (16 * ks) * VP + d * 64), hi = vtr(Vb + (16 * ks + 8) * VP + d * 64);
                    const bf16x8 vf = {lo[0], lo[1], lo[2], lo[3], hi[0], hi[1], hi[2], hi[3]};
                    o[d] = __builtin_amdgcn_mfma_f32_32x32x16_bf16(vf, pf, o[d], 0, 0, 0);
                }
                __builtin_amdgcn_sched_barrier(0);
            }
        }
        if (t + 1 < NT) ATT_STORE(buf ^ 1);
        __syncthreads();
    }
    lrun += __shfl_xor(lrun, 32);
    const float il = 1.f / lrun;
    bf16* orow = OA + (rowbase + q0 + r32) * 2048 + h * 128 + 4 * hh;
#pragma unroll
    for (int d = 0; d < 4; ++d)
#pragma unroll
        for (int g = 0; g < 4; ++g) {
            const unsigned w0 = cvtpk(o[d][4 * g] * il, o[d][4 * g + 1] * il), w1 = cvtpk(o[d][4 * g + 2] * il, o[d][4 * g + 3] * il);
            *(GAS unsigned long long*)(orow + d * 32 + 8 * g) = (unsigned long long)w0 | ((unsigned long long)w1 << 32);
        }
#undef ATT_LOAD
#undef ATT_STORE
}
}

struct Frame {
    LAS unsigned char* lds;
    volatile LAS unsigned* MISC;
    gu32* ctl;
    int tid, lane, wave, vcu, G;
};
__device__ __forceinline__ float wave_sum(float v) {
#pragma unroll
    for (int o = 1; o < 64; o <<= 1) v += __shfl_xor(v, o);
    return v;
}
__device__ __forceinline__ float bf2f(bf16 h) { return __uint_as_float(((unsigned)h) << 16); }
__device__ __forceinline__ float bflo(unsigned w) { return __uint_as_float(w << 16); }
__device__ __forceinline__ float bfhi(unsigned w) { return __uint_as_float(w & 0xffff0000u); }

template <class RowMap>
__device__ __forceinline__ void p0_transpose_item(const float* W, int K, int N, bf16* WT, const RowMap rm, float scale, LAS float* scr, int item, int lane) {
    const int nblk = N / 32, kb = item / nblk, nb = item % nblk, k0 = 64 * kb, n0 = 32 * nb;
#pragma unroll 8
    for (int i = 0; i < 32; ++i) { const int kk = 2 * i + (lane >> 5); scr[kk * 33 + (lane & 31)] = W[(size_t)(k0 + kk) * N + n0 + (lane & 31)]; }
    LDS_WAIT(); asm volatile("" ::: "memory");
    const int c = lane & 7;
#pragma unroll
    for (int j = 0; j < 4; ++j) { const int n = (lane >> 3) + 8 * j; const LAS float* s = scr + (8 * c) * 33 + n;
        v4u o; o.x = pk2(s[0 * 33] * scale, s[1 * 33] * scale); o.y = pk2(s[2 * 33] * scale, s[3 * 33] * scale); o.z = pk2(s[4 * 33] * scale, s[5 * 33] * scale); o.w = pk2(s[6 * 33] * scale, s[7 * 33] * scale);
        *(GAS v4u*)(WT + (size_t)rm(n0 + n) * K + k0 + 8 * c) = o; }
    LDS_WAIT(); asm volatile("" ::: "memory");
}
struct RmId { int off; __device__ __forceinline__ int operator()(int n) const { return n + off; } };
struct RmWin { __device__ __forceinline__ int operator()(int n) const { if (n < 1536) return n; if (n < 1600) { const int i = n - 1536; return 1536 + ((i & 31) << 1) + (i >> 5); } return n + 192; } };
struct RmUq { __device__ __forceinline__ int operator()(int n) const { const int hd = n / 192, w = n - hd * 192; if (w < 128) return n; const int i = w - 128; return hd * 192 + 128 + ((i & 31) << 1) + (i >> 5); } };
struct RmGu { int up; __device__ __forceinline__ int operator()(int n) const { return ((n >> 7) << 8) + (n & 127) + up; } };

template <bool WF32, bool WBF, bool WST>
__device__ __forceinline__ void ln_row(const float* xrow, const float* g, const float* b, float* of, bf16* ob, float* st, int lane) {
    const GAS f32x4* xr = (const GAS f32x4*)xrow + lane;
    f32x4 v[16]; float s = 0.f;
#pragma unroll
    for (int j = 0; j < 16; ++j) { v[j] = xr[64 * j]; s += (v[j].x + v[j].y) + (v[j].z + v[j].w); }
    const float mean = wave_sum(s) * (1.f / 4096.f); float s2 = 0.f;
#pragma unroll
    for (int j = 0; j < 16; ++j) { v[j] = v[j] - mean; s2 += (v[j].x * v[j].x + v[j].y * v[j].y) + (v[j].z * v[j].z + v[j].w * v[j].w); }
    const float rstd = 1.f / sqrtf(wave_sum(s2) * (1.f / 4096.f) + LN_EPS);
    if (WST) { if (lane == 0) { st[0] = mean; st[1] = rstd; } }
    const GAS f32x4* gr = (const GAS f32x4*)g + lane; const GAS f32x4* br = (const GAS f32x4*)b + lane;
#pragma unroll
    for (int j = 0; j < 16; ++j) { const f32x4 o = v[j] * rstd * gr[64 * j] + br[64 * j];
        if (WF32) ((GAS f32x4*)of)[lane + 64 * j] = o;
        if (WBF) ((GAS unsigned long long*)ob)[lane + 64 * j] = (unsigned long long)pk2(o.x, o.y) | ((unsigned long long)pk2(o.z, o.w) << 32); }
}

struct Args { const void* in[21]; float* out; unsigned char* ws; int ph_lo, ph_hi; };
__global__ void __launch_bounds__(NWAVES * 64, 2) mega_fwd(Args args) {
    extern __shared__ __attribute__((aligned(16))) unsigned char lds[];
    Frame F;
    F.lds = (LAS unsigned char*)lds;
    F.MISC = (volatile LAS unsigned*)(F.lds + MISC_OFF);
    F.tid = threadIdx.x; F.lane = F.tid & 63; F.wave = __builtin_amdgcn_readfirstlane(F.tid >> 6);
    F.G = gridDim.x; { const int bx = blockIdx.x; F.vcu = (F.G % 8 == 0) ? (bx % 8) * (F.G / 8) + bx / 8 : bx; }
    unsigned char* ws = args.ws;
    F.ctl = (gu32*)(ws + WS_CTL);
    const float* x = (const float*)args.in[0]; const int* positions = (const int*)args.in[1];
    const float* ln_in_g = (const float*)args.in[2]; const float* ln_in_b = (const float*)args.in[3];
    const float* w_in = (const float*)args.in[4]; const float* q_norm_g = (const float*)args.in[5]; const float* w_uq = (const float*)args.in[6];
    const float* kv_norm_g = (const float*)args.in[7]; const float* w_ukv = (const float*)args.in[8]; const float* hg_lb = (const float*)args.in[9];
    const float* hg_norm_g = (const float*)args.in[10]; const float* w_a = (const float*)args.in[11]; const float* w_b = (const float*)args.in[12];
    const float* w_out = (const float*)args.in[13]; const float* ln1_g = (const float*)args.in[14]; const float* ln1_b = (const float*)args.in[15];
    const float* w_gate = (const float*)args.in[16]; const float* w_up = (const float*)args.in[17]; const float* w_down = (const float*)args.in[18];
    const float* ln2_g = (const float*)args.in[19]; const float* ln2_b = (const float*)args.in[20];
    float* out = args.out;
    bf16* Wt_in = (bf16*)(ws + WS_WIN); bf16* Wt_uq = (bf16*)(ws + WS_WUQ); bf16* Wt_ukv = (bf16*)(ws + WS_WUKV); bf16* Wt_ab = (bf16*)(ws + WS_WAB);
    bf16* Wt_out = (bf16*)(ws + WS_WOUT); bf16* Wt_gu = (bf16*)(ws + WS_WGU); bf16* Wt_down = (bf16*)(ws + WS_WDOWN);
    bf16* HB = (bf16*)(ws + WS_HB); float* CS = (float*)(ws + WS_CS); float* ST = (float*)(ws + WS_ST);
    float* CF = (float*)(ws + WS_CF); bf16* QH = (bf16*)(ws + WS_QH); float* GL = (float*)(ws + WS_G); bf16* HI = (bf16*)(ws + WS_HI); bf16* GS = (bf16*)(ws + WS_GS);
    bf16* GA = (bf16*)(ws + WS_GA); bf16* GB = (bf16*)(ws + WS_GB);
    bf16* Q = (bf16*)(ws + WS_Q); bf16* KV = (bf16*)(ws + WS_KV); bf16* CQN = (bf16*)(ws + WS_CQN); bf16* CKVN = (bf16*)(ws + WS_CKVN); bf16* KROPE = (bf16*)(ws + WS_KROPE);
    bf16* OAB = (bf16*)(ws + WS_OAB); bf16* MERGED = (bf16*)(ws + WS_KV); float* R = (float*)(ws + WS_R); bf16* ACT = (bf16*)(ws + WS_ACT);

    for (int u = F.tid; u < (LDS_BYTES - LDSCTL_OFF) / 4; u += NWAVES * 64) ((LAS unsigned*)(F.lds + LDSCTL_OFF))[u] = 0u;
    __syncthreads();
#if MK_ONE_LAUNCH
    XcdBarrier bar = xcd_barrier_post((unsigned*)(F.ctl + CW_BAR), F.MISC + 8);
#define GRID_BAR() xcd_barrier(bar)
#else
#define GRID_BAR() do {} while (0)
#endif
    const int lo = args.ph_lo, hi = args.ph_hi;
#define IN(k) (lo <= (k) && (k) < hi)
#define BOTH(k) (IN(k) && IN((k) + 1))
    const int gw = F.vcu * NWAVES + F.wave, NGW = F.G * NWAVES;
    const int gt = blockIdx.x * (NWAVES * 64) + F.tid, NGT = F.G * NWAVES * 64;

    if (IN(0)) {
        LAS float* scr = (LAS float*)(F.lds + RING_OFF + F.wave * 16384);
        constexpr int I_IN = (DM / 64) * (17984 / 32), I_UQ = (1024 / 64) * (3072 / 32), I_UKV = (512 / 64) * (4096 / 32), I_A = (2048 / 64) * (4096 / 32), I_B = I_A,
                      I_OUT = (4096 / 64) * (4096 / 32), I_G = (4096 / 64) * (DFF / 32), I_U = I_G, I_D = (DFF / 64) * (4096 / 32);
        constexpr int NITEMS = I_IN + I_UQ + I_UKV + I_A + I_B + I_OUT + I_G + I_U + I_D;
        for (int it = gw; it < NITEMS; it += NGW) {
            int r = it;
            if (r < I_IN) { p0_transpose_item(w_in, DM, 17984, Wt_in, RmWin{}, 1.f, scr, r, F.lane); continue; } r -= I_IN;
            if (r < I_UQ) { p0_transpose_item(w_uq, 1024, 3072, Wt_uq, RmUq{}, QSCALE, scr, r, F.lane); continue; } r -= I_UQ;
            if (r < I_UKV) { p0_transpose_item(w_ukv, 512, 4096, Wt_ukv, RmId{0}, 1.f, scr, r, F.lane); continue; } r -= I_UKV;
            if (r < I_A) { p0_transpose_item(w_a, 2048, 4096, Wt_ab, RmId{0}, 1.f, scr, r, F.lane); continue; } r -= I_A;
            if (r < I_B) { p0_transpose_item(w_b, 2048, 4096, Wt_ab, RmId{4096}, 1.f, scr, r, F.lane); continue; } r -= I_B;
            if (r < I_OUT) { p0_transpose_item(w_out, 4096, 4096, Wt_out, RmId{0}, 1.f, scr, r, F.lane); continue; } r -= I_OUT;
            if (r < I_G) { p0_transpose_item(w_gate, 4096, DFF, Wt_gu, RmGu{0}, 1.f, scr, r, F.lane); continue; } r -= I_G;
            if (r < I_U) { p0_transpose_item(w_up, 4096, DFF, Wt_gu, RmGu{128}, 1.f, scr, r, F.lane); continue; } r -= I_U;
            p0_transpose_item(w_down, DFF, 4096, Wt_down, RmId{0}, 1.f, scr, r, F.lane);
        }
        for (int i = gt; i < 192 * DM / 8; i += NGT) ((GAS v4u*)(Wt_in + (size_t)1600 * DM))[i] = (v4u){0u, 0u, 0u, 0u};
        for (int m = gw; m < MTOK; m += NGW) ln_row<false, true, true>(x + (size_t)m * DM, ln_in_g, ln_in_b, nullptr, HB + (size_t)m * DM, ST + 2 * m, F.lane);
        for (int i = gt; i < MTOK * 32; i += NGT) { const int row = i >> 5, k = i & 31;
            const float inv = exp2f(-(float)k * (13.287712379549449f / 32.f)); const float ang = (float)positions[row] * inv;
            CS[(size_t)row * 64 + k] = cosf(ang); CS[(size_t)row * 64 + 32 + k] = sinf(ang); }
        if (BOTH(0)) GRID_BAR();
    }
    if (IN(1)) {
        pg8::Gemm g{HB, Wt_in, MTOK, NPROJ, DM}; pg8::StaticOrder S; S.init(MTOK, NPROJ, F.G, (int)blockIdx.x);
        pg8::EpiProj E{CF, QH, GL, HI, GS, GA, GB, hg_lb};
        pg8::gemm_phase<pg8::EpiProj, pg8::StaticOrder, true, true>(F.lds + RING_OFF, g, S, E);
        if (BOTH(1)) GRID_BAR();
    }
    if (IN(2)) {
        for (int m = gw; m < MTOK; m += NGW) {
            const float* cf = CF + (size_t)m * 1792;
            { const GAS f32x4* p = (const GAS f32x4*)cf + F.lane; f32x4 v[4]; float s = 0.f;
#pragma unroll
              for (int j = 0; j < 4; ++j) { v[j] = p[64 * j]; s += (v[j].x * v[j].x + v[j].y * v[j].y) + (v[j].z * v[j].z + v[j].w * v[j].w); }
              const float rs = 1.f / sqrtf(wave_sum(s) * (1.f / 1024.f) + LN_EPS);
#pragma unroll
              for (int j = 0; j < 4; ++j) { const f32x4 gg = ((const GAS f32x4*)q_norm_g)[F.lane + 64 * j]; const f32x4 o = v[j] * rs * gg;
                  ((GAS unsigned long long*)(CQN + (size_t)m * 1024))[F.lane + 64 * j] = (unsigned long long)pk2(o.x, o.y) | ((unsigned long long)pk2(o.z, o.w) << 32); } }
            { const GAS f32x4* p = (const GAS f32x4*)(cf + 1024) + F.lane; f32x4 v[2]; float s = 0.f;
#pragma unroll
              for (int j = 0; j < 2; ++j) { v[j] = p[64 * j]; s += (v[j].x * v[j].x + v[j].y * v[j].y) + (v[j].z * v[j].z + v[j].w * v[j].w); }
              const float rs = 1.f / sqrtf(wave_sum(s) * (1.f / 512.f) + LN_EPS);
#pragma unroll
              for (int j = 0; j < 2; ++j) { const f32x4 gg = ((const GAS f32x4*)kv_norm_g)[F.lane + 64 * j]; const f32x4 o = v[j] * rs * gg;
                  ((GAS unsigned long long*)(CKVN + (size_t)m * 512))[F.lane + 64 * j] = (unsigned long long)pk2(o.x, o.y) | ((unsigned long long)pk2(o.z, o.w) << 32); } }
            if (F.lane < 32) { const float x1 = cf[1536 + 2 * F.lane], x2 = cf[1536 + 2 * F.lane + 1], c = CS[(size_t)m * 64 + F.lane], s = CS[(size_t)m * 64 + 32 + F.lane];
                ((GAS unsigned*)(KROPE + (size_t)m * 64))[F.lane] = pk2(x1 * c - x2 * s, x1 * s + x2 * c); }
        }
        if (BOTH(2)) GRID_BAR();
    }
    if (IN(3)) {
        { pg8::Gemm g{CQN, Wt_uq, MTOK, 3072, 1024}; pg8::StaticOrder S; S.init(MTOK, 3072, F.G, (int)blockIdx.x);
          pg8::EpiQ E{Q, CS};
          pg8::gemm_phase<pg8::EpiQ, pg8::StaticOrder, true, true>(F.lds + RING_OFF, g, S, E); }
        { pg8::Gemm g{CKVN, Wt_ukv, MTOK, 4096, 512}; pg8::StaticOrder S; S.init(MTOK, 4096, F.G, (int)blockIdx.x);
          pg8::EpiPlain E{KV, 4096};
          pg8::gemm_phase<pg8::EpiPlain, pg8::StaticOrder, true, true>(F.lds + RING_OFF, g, S, E); }
        if (BOTH(3)) GRID_BAR();
    }
    if (IN(4)) {
        for (int w = F.vcu; w < 256; w += F.G) {
            const int bh = w >> 2, s = w & 3;
            att::attn_unit(F.lds + RING_OFF, Q, KV, KROPE, OAB, bh >> 4, bh & 15, s, F.tid);
            att::attn_unit(F.lds + RING_OFF, Q, KV, KROPE, OAB, bh >> 4, bh & 15, 7 - s, F.tid);
        }
        __syncthreads();
        for (int bh = blockIdx.x; bh < 64; bh += F.G) {
            const int b = bh >> 4, h = bh & 15;
            LAS float* sf = (LAS float*)(F.lds + RING_OFF); LAS float* sk = sf + 16 * 128; LAS float* sq = sk + 16 * 128; LAS float* so = sq + 16 * 128;
            float S[128];
#pragma unroll
            for (int k = 0; k < 128; ++k) S[k] = 0.f;
            for (int t0 = 0; t0 < 2048; t0 += 16) {
#pragma unroll
                for (int i = 0; i < 4; ++i) { const int idx = F.tid + 512 * i, tt = idx >> 7, k = idx & 127; const size_t off = (size_t)(b * 2048 + t0 + tt) * 2048 + h * 128 + k;
                    const float f = __expf(GL[off]); sf[idx] = f; sk[idx] = 1.f - f; sq[idx] = bf2f(QH[off]); }
                __syncthreads();
                if (F.tid < 128) {
                    for (int tt = 0; tt < 16; ++tt) {
                        const float vv = bf2f(HI[(size_t)(b * 2048 + t0 + tt) * 2048 + h * 128 + F.tid]); float o = 0.f;
#pragma unroll
                        for (int k = 0; k < 128; ++k) { S[k] = sf[tt * 128 + k] * S[k] + sk[tt * 128 + k] * vv; o += S[k] * sq[tt * 128 + k]; }
                        so[tt * 128 + F.tid] = o;
                    }
                }
                __syncthreads();
                { const int tt = F.tid >> 5, v4 = (F.tid & 31) * 4; const f32x4 o = *(LAS f32x4*)(so + tt * 128 + v4);
                  float s = (o.x * o.x + o.y * o.y) + (o.z * o.z + o.w * o.w);
#pragma unroll
                  for (int d = 1; d < 32; d <<= 1) s += __shfl_xor(s, d);
                  const float rs = 1.f / sqrtf(s * (1.f / 128.f) + LN_EPS);
                  const size_t off = (size_t)(b * 2048 + t0 + tt) * 2048 + h * 128 + v4;
                  const f32x4 gn = *(const f32x4*)(hg_norm_g + v4); const unsigned long long gsw = *(const GAS unsigned long long*)(GS + off);
                  const unsigned g01 = (unsigned)gsw, g23 = (unsigned)(gsw >> 32);
                  const float r0 = o.x * rs * gn.x * bflo(g01), r1 = o.y * rs * gn.y * bfhi(g01), r2 = o.z * rs * gn.z * bflo(g23), r3 = o.w * rs * gn.w * bfhi(g23);
                  *(GAS unsigned long long*)(OAB + (size_t)MTOK * 2048 + off) = (unsigned long long)pk2(r0, r1) | ((unsigned long long)pk2(r2, r3) << 32); }
                __syncthreads();
            }
        }
        if (BOTH(4)) GRID_BAR();
    }
    if (IN(5)) {
        pg8::Gemm g{OAB, Wt_ab, 2 * MTOK, 8192, 2048}; pg8::DualOrder S; S.S.init(MTOK, 4096, F.G, (int)blockIdx.x);
        pg8::EpiMerge E{GA, GB, MERGED};
        pg8::gemm_phase<pg8::EpiMerge, pg8::DualOrder, true, true>(F.lds + RING_OFF, g, S, E);
        if (BOTH(5)) GRID_BAR();
    }
    if (IN(6)) {
        pg8::Gemm g{MERGED, Wt_out, MTOK, 4096, 4096}; pg8::StaticOrder S; S.init(MTOK, 4096, F.G, (int)blockIdx.x);
        pg8::EpiMix E{x, ST, ln_in_g, ln_in_b, R, ALPHA};
        pg8::gemm_phase<pg8::EpiMix, pg8::StaticOrder, true, true>(F.lds + RING_OFF, g, S, E);
        if (BOTH(6)) GRID_BAR();
    }
    if (IN(7)) {
        for (int m = gw; m < MTOK; m += NGW) ln_row<true, true, false>(R + (size_t)m * DM, ln1_g, ln1_b, R + (size_t)m * DM, HB + (size_t)m * DM, nullptr, F.lane);
        if (BOTH(7)) GRID_BAR();
    }
    if (IN(8)) {
        pg8::Gemm g{HB, Wt_gu, MTOK, 2 * DFF, DM}; pg8::StaticOrder S; S.init(MTOK, 2 * DFF, F.G, (int)blockIdx.x);
        pg8::EpiSwiglu E{ACT};
        pg8::gemm_phase<pg8::EpiSwiglu, pg8::StaticOrder, true, true>(F.lds + RING_OFF, g, S, E);
        if (BOTH(8)) GRID_BAR();
    }
    if (IN(9)) {
        pg8::Gemm g{ACT, Wt_down, MTOK, 4096, DFF}; pg8::StaticOrder S; S.init(MTOK, 4096, F.G, (int)blockIdx.x);
        pg8::EpiDown E{R, out, ALPHA};
        pg8::gemm_phase<pg8::EpiDown, pg8::StaticOrder, true, true>(F.lds + RING_OFF, g, S, E);
        if (BOTH(9)) GRID_BAR();
    }
    if (IN(10)) {
        for (int m = gw; m < MTOK; m += NGW) ln_row<true, false, false>(out + (size_t)m * DM, ln2_g, ln2_b, out + (size_t)m * DM, nullptr, nullptr, F.lane);
    }
#undef IN
#undef BOTH
}

extern "C" void kernel_launch(void* const* d_in, const int* in_sizes, int n_in, void* d_out, int out_size, void* d_ws, size_t ws_size, hipStream_t stream) {
    static int grid = 0;
    if (grid == 0) {
        if (n_in != 21 || out_size != MTOK * DM || ws_size < WS_END) { fprintf(stderr, "kernel_launch: unexpected shapes (n_in %d, out %d, ws %zu, need %zu)\n", n_in, out_size, ws_size, (size_t)WS_END); grid = -1; return; }
        int dev = 0, cus = 0, per_cu = 0;
        if (hipGetDevice(&dev) != hipSuccess || hipDeviceGetAttribute(&cus, hipDeviceAttributeMultiprocessorCount, dev) != hipSuccess) { grid = -1; return; }
        if (hipFuncSetAttribute((const void*)mega_fwd, hipFuncAttributeMaxDynamicSharedMemorySize, LDS_BYTES) != hipSuccess) { fprintf(stderr, "kernel_launch: hipFuncSetAttribute failed\n"); grid = -1; return; }
        if (hipOccupancyMaxActiveBlocksPerMultiprocessor(&per_cu, (const void*)mega_fwd, NWAVES * 64, LDS_BYTES) != hipSuccess || per_cu < 1)
            fprintf(stderr, "kernel_launch: note: occupancy query reports %d workgroups per CU\n", per_cu);
        (void)hipGetLastError();
        grid = cus;
    }
    if (grid < 0) return;
    if (hipMemsetAsync((char*)d_ws + WS_CTL, 0, CTL_ZERO_BYTES, stream) != hipSuccess) return;
    Args a{};
    for (int i = 0; i < 21; ++i) a.in[i] = d_in[i];
    a.out = (float*)d_out; a.ws = (unsigned char*)d_ws;
#if MK_ONE_LAUNCH
    a.ph_lo = 0; a.ph_hi = NPHASE;
    hipLaunchKernelGGL(mega_fwd, dim3(grid), dim3(NWAVES * 64), LDS_BYTES, stream, a);
#else
    for (int p = 0; p < NPHASE; ++p) { a.ph_lo = p; a.ph_hi = p + 1; hipLaunchKernelGGL(mega_fwd, dim3(grid), dim3(NWAVES * 64), LDS_BYTES, stream, a); }
#endif
}
```

```cpp
#include <hip/hip_runtime.h>
#include <cstdio>
#include <cstdint>
namespace pg8 {
#define PG8_LAS __attribute__((address_space(3)))
typedef unsigned short bf16_t;
typedef short bf16x8 __attribute__((ext_vector_type(8)));
typedef float f32x4 __attribute__((ext_vector_type(4)));
typedef unsigned u32x4 __attribute__((ext_vector_type(4)));
constexpr int BM = 256, BK = 64, HALF = 128, HTB = HALF * BK * 2  , STAGE_BYTES = 8 * HTB, NXCD = 8, WGM = 8;

__host__ __device__ __forceinline__ int lds_byte(int r, int c) { const int st = (r >> 4) * 2 + (c >> 5), rr = r & 15, cc = c & 31, ob = rr * 64 + cc * 2; return st * 1024 + (ob ^ (((ob >> 9) & 1) << 5)); }
__host__ __device__ __forceinline__ void stage_rc(int b, int& R, int& C) { const int st = b / 1024, sb = b % 1024, swz = sb ^ (((sb >> 9) & 1) << 5); R = (st >> 1) * 16 + swz / 64; C = (st & 1) * 32 + (swz % 64) / 2; }
__host__ __device__ __forceinline__ int perm32(int rho) { const int n = rho >> 4, i = rho & 15; return 8 * (i >> 2) + 4 * n + (i & 3); }

struct Unit { int pm, pn; };
struct Gemm { const bf16_t* A; const bf16_t* Bt; int M, N, K; };

struct StaticOrder {
    int nM, nN, nwg, G, c;
    __host__ __device__ void init(int M, int N, int G_, int c_) { nM = M / BM; nN = N / BM; nwg = nM * nN; G = G_; c = c_; }
    __host__ __device__ bool next(int i, Unit& u) const {
        const long L = (long)i * G + c; if (L >= nwg) return false;
        int wgid = (int)L; { const int q = nwg / NXCD, r = nwg % NXCD, xcd = wgid % NXCD, off = wgid / NXCD; wgid = (xcd < r ? xcd * (q + 1) : r * (q + 1) + (xcd - r) * q) + off; }
        const int nig = WGM * nN, gid = wgid / nig, fm = gid * WGM, gsz = (nM - fm) < WGM ? (nM - fm) : WGM;
        u.pm = fm + ((wgid % nig) % gsz); u.pn = (wgid % nig) / gsz; return true;
    }
    __device__ __forceinline__ void a_ready(const Unit&) const {}
    __device__ __forceinline__ void done(const Unit&) const {}
};

__device__ __forceinline__ unsigned cvt_pk_bf16(float lo, float hi) { unsigned r; asm volatile("v_cvt_pk_bf16_f32 %0, %1, %2" : "=v"(r) : "v"(lo), "v"(hi)); return r; }
typedef float f32x2 __attribute__((ext_vector_type(2)));
__device__ __forceinline__ f32x2 gelu_pk(f32x2 v) {
    const f32x2 av = __builtin_elementwise_abs(v), d = av * 0.2316418882f + 1.0f;
    f32x2 t; t.x = __builtin_amdgcn_rcpf(d.x); t.y = __builtin_amdgcn_rcpf(d.y);
    f32x2 q = t * 0.5307027145f + (-0.7265760135f); q = q * t + 0.7107068705f; q = q * t + (-0.142248368f); q = q * t + 0.127414796f; q = q * t;
    const f32x2 s = (v * v) * (-0.72134752044f);
    f32x2 e; e.x = __builtin_amdgcn_exp2f(s.x); e.y = __builtin_amdgcn_exp2f(s.y);
    const f32x2 m = v * (q * e), r = v - m;
    f32x2 o; o.x = v.x < 0.f ? m.x : r.x; o.y = v.y < 0.f ? m.y : r.y; return o;
}

template <class Epi, class Sched, bool ALIGN_EPI = false, bool SP2 = false>
__device__ __forceinline__ void gemm_phase(PG8_LAS unsigned char* lds, const Gemm g, const Sched& S, const Epi& E) {
    const int tid = threadIdx.x, wid = __builtin_amdgcn_readfirstlane(tid >> 6), lane = tid & 63, wr = wid >> 2, wc = wid & 3, fr = lane & 15, fq = lane >> 4;
    const int K = g.K, nt = K / BK;
    unsigned voffA[2], voffB[2];
#pragma unroll
    for (int i = 0; i < 2; ++i) { int R, C; stage_rc(tid * 16 + i * 8192, R, C); const int Rb = Epi::PERM ? ((R & ~31) + perm32(R & 31)) : R;
        voffA[i] = (unsigned)(R * K + C) * 2u; voffB[i] = (unsigned)(Rb * K + C) * 2u; }
    const size_t kstep = (size_t)(BK * 2);
    const size_t hstep = (size_t)HALF * K * 2;
    const size_t tstep = 2 * hstep;
    const unsigned ldsw = (unsigned)wid * 1024u;
    const int aoff = lds_byte(wr * 64 + fr, fq * 8), boff = lds_byte(wc * 32 + fr, fq * 8);
#define PG8_SA(b, h) (((b) * 2 + (h)) * HTB)
#define PG8_SB(b, h) ((4 + (b) * 2 + (h)) * HTB)
#define PG8_STAGE(bufoff, gbase, voff) do { _Pragma("unroll") for (int _i = 0; _i < 2; ++_i) \
        __builtin_amdgcn_global_load_lds((const unsigned*)((const char*)(gbase) + (voff)[_i]), (PG8_LAS unsigned*)(lds + (bufoff) + ldsw + _i * 8192), 16, 0, 0); } while (0)
#define PG8_LDA(dst, b, h) do { _Pragma("unroll") for (int m = 0; m < 4; ++m) _Pragma("unroll") for (int k = 0; k < 2; ++k) dst[m][k] = *(const PG8_LAS bf16x8*)(lds + PG8_SA(b, h) + aoff + m * 2048 + k * 1024); } while (0)
#define PG8_LDB(dst, b, h) do { _Pragma("unroll") for (int n = 0; n < 2; ++n) _Pragma("unroll") for (int k = 0; k < 2; ++k) dst[n][k] = *(const PG8_LAS bf16x8*)(lds + PG8_SB(b, h) + boff + n * 2048 + k * 1024); } while (0)
#define PG8_MMA(ai, bj, At, Bt) do { __builtin_amdgcn_s_setprio(1); _Pragma("unroll") for (int m = 0; m < 4; ++m) _Pragma("unroll") for (int n = 0; n < 2; ++n) _Pragma("unroll") for (int k = 0; k < 2; ++k) \
        acc[ai][bj][m][n] = __builtin_amdgcn_mfma_f32_16x16x32_bf16(Bt[n][k], At[m][k], acc[ai][bj][m][n], 0, 0, 0); __builtin_amdgcn_s_setprio(0); } while (0)
#define PG8_WAIT_V(n) asm volatile("s_waitcnt vmcnt(" #n ")" ::: "memory")
#define PG8_WAIT_L(n) asm volatile("s_waitcnt lgkmcnt(" #n ")" ::: "memory")
#define PG8_BAR __builtin_amdgcn_s_barrier()
#define PG8_SCHED __builtin_amdgcn_sched_barrier(0)
    Unit cur, nxt; int ui = 0;
    if (!S.next(0, cur)) return;
    f32x4 acc[2][2][4][2];
#pragma unroll
    for (int a = 0; a < 2; ++a)
#pragma unroll
        for (int b = 0; b < 2; ++b)
#pragma unroll
            for (int m = 0; m < 4; ++m)
#pragma unroll
                for (int n = 0; n < 2; ++n) acc[a][b][m][n] = (f32x4){0.f, 0.f, 0.f, 0.f};
    bf16x8 At[4][2], B0[2][2], B1[2][2];
    const char* cA = (const char*)g.A + (size_t)cur.pm * tstep; const char* cB = (const char*)g.Bt + (size_t)cur.pn * tstep;
    S.a_ready(cur);
    if constexpr (SP2) {
        PG8_STAGE(PG8_SB(0, 0), cB, voffB); PG8_STAGE(PG8_SB(0, 1), cB + hstep, voffB); PG8_STAGE(PG8_SA(0, 0), cA, voffA); PG8_STAGE(PG8_SA(0, 1), cA + hstep, voffA);
        if (wr == 1) PG8_BAR;
        PG8_WAIT_V(2); PG8_BAR;
        PG8_STAGE(PG8_SB(1, 0), cB + kstep, voffB); PG8_STAGE(PG8_SA(1, 0), cA + kstep, voffA); PG8_STAGE(PG8_SB(1, 1), cB + hstep + kstep, voffB);
        PG8_WAIT_V(6); PG8_BAR;
    } else {
        PG8_STAGE(PG8_SB(0, 0), cB, voffB); PG8_STAGE(PG8_SA(0, 0), cA, voffA); PG8_STAGE(PG8_SB(0, 1), cB + hstep, voffB); PG8_STAGE(PG8_SA(0, 1), cA + hstep, voffA);
        if (wr == 1) PG8_BAR;
        PG8_WAIT_V(4); PG8_BAR;
        PG8_STAGE(PG8_SB(1, 0), cB + kstep, voffB); PG8_STAGE(PG8_SA(1, 0), cA + kstep, voffA); PG8_STAGE(PG8_SB(1, 1), cB + hstep + kstep, voffB);
        PG8_WAIT_V(6); PG8_BAR;
    }
    for (;;) {
        const bool has_next = S.next(ui + 1, nxt);
        const char* nA = has_next ? (const char*)g.A + (size_t)nxt.pm * tstep : cA; const char* nB = has_next ? (const char*)g.Bt + (size_t)nxt.pn * tstep : cB;
        for (int t = 0; t < nt; t += 2) {
            const bool last = (t == nt - 2);
            const char* a1 = cA + (size_t)(t + 1) * kstep;
            const char* a2 = last ? nA : cA + (size_t)(t + 2) * kstep; const char* b2 = last ? nB : cB + (size_t)(t + 2) * kstep;
            const char* a3 = a2 + kstep; const char* b3 = b2 + kstep;
            if (last && has_next) S.a_ready(nxt);
            if constexpr (SP2) {
            PG8_LDB(B0, 0, 0); PG8_LDB(B1, 0, 1); PG8_SCHED; PG8_LDA(At, 0, 0); PG8_STAGE(PG8_SA(1, 1), a1 + hstep, voffA);
            PG8_WAIT_V(8); PG8_WAIT_L(0); PG8_BAR; PG8_MMA(0, 0, At, B0); PG8_MMA(0, 1, At, B1); PG8_BAR; PG8_SCHED;
            PG8_LDA(At, 0, 1); PG8_STAGE(PG8_SB(0, 0), b2, voffB); PG8_STAGE(PG8_SB(0, 1), b2 + hstep, voffB); PG8_STAGE(PG8_SA(0, 0), a2, voffA);
            PG8_WAIT_V(8); PG8_WAIT_L(0); PG8_BAR; PG8_MMA(1, 0, At, B0); PG8_MMA(1, 1, At, B1); PG8_BAR; PG8_SCHED;
            PG8_LDB(B0, 1, 0); PG8_LDB(B1, 1, 1); PG8_SCHED; PG8_LDA(At, 1, 0); PG8_STAGE(PG8_SA(0, 1), a2 + hstep, voffA);
            PG8_WAIT_V(8); PG8_WAIT_L(0); PG8_BAR; PG8_MMA(0, 0, At, B0); PG8_MMA(0, 1, At, B1); PG8_BAR; PG8_SCHED;
            PG8_LDA(At, 1, 1); PG8_STAGE(PG8_SB(1, 0), b3, voffB); PG8_STAGE(PG8_SB(1, 1), b3 + hstep, voffB); PG8_STAGE(PG8_SA(1, 0), a3, voffA);
            PG8_WAIT_V(8); PG8_WAIT_L(0); PG8_BAR; PG8_MMA(1, 0, At, B0); PG8_MMA(1, 1, At, B1); PG8_BAR; PG8_SCHED;
            } else {
            PG8_LDB(B0, 0, 0); PG8_SCHED; PG8_LDA(At, 0, 0); PG8_STAGE(PG8_SA(1, 1), a1 + hstep, voffA);
            PG8_WAIT_L(8); PG8_BAR; PG8_WAIT_L(0); PG8_MMA(0, 0, At, B0); PG8_BAR; PG8_SCHED;
            PG8_LDB(B1, 0, 1); PG8_STAGE(PG8_SB(0, 0), b2, voffB);
            PG8_BAR; PG8_WAIT_L(0); PG8_MMA(0, 1, At, B1); PG8_BAR;
            PG8_LDA(At, 0, 1); PG8_STAGE(PG8_SA(0, 0), a2, voffA);
            PG8_BAR; PG8_WAIT_L(0); PG8_MMA(1, 0, At, B0); PG8_BAR; PG8_SCHED;
            PG8_STAGE(PG8_SB(0, 1), b2 + hstep, voffB);
            PG8_WAIT_V(6); PG8_BAR; PG8_MMA(1, 1, At, B1); PG8_BAR;
            PG8_LDB(B0, 1, 0); PG8_SCHED; PG8_LDA(At, 1, 0); PG8_STAGE(PG8_SA(0, 1), a2 + hstep, voffA);
            PG8_WAIT_L(8); PG8_BAR; PG8_WAIT_L(0); PG8_MMA(0, 0, At, B0); PG8_BAR; PG8_SCHED;
            PG8_LDB(B1, 1, 1); PG8_STAGE(PG8_SB(1, 0), b3, voffB);
            PG8_BAR; PG8_WAIT_L(0); PG8_MMA(0, 1, At, B1); PG8_BAR;
            PG8_LDA(At, 1, 1); PG8_STAGE(PG8_SA(1, 0), a3, voffA);
            PG8_BAR; PG8_WAIT_L(0); PG8_MMA(1, 0, At, B0); PG8_BAR; PG8_SCHED;
            PG8_STAGE(PG8_SB(1, 1), b3 + hstep, voffB);
            PG8_WAIT_V(6); PG8_BAR; PG8_MMA(1, 1, At, B1); PG8_BAR;
            }
        }
        if constexpr (ALIGN_EPI) { if (wr == 0) PG8_BAR; }
        if constexpr (!Epi::AFTER_DRAIN) { E(acc, cur, wr, wc, fr, fq); S.done(cur); }
        if (!has_next) break;
        if (!E.keep(cur)) {
#pragma unroll
        for (int a = 0; a < 2; ++a)
#pragma unroll
            for (int b = 0; b < 2; ++b)
#pragma unroll
                for (int m = 0; m < 4; ++m)
#pragma unroll
                    for (int n = 0; n < 2; ++n) acc[a][b][m][n] = (f32x4){0.f, 0.f, 0.f, 0.f};
        }
        cur = nxt; cA = nA; cB = nB; ++ui;
        if constexpr (ALIGN_EPI) { if (wr == 1) PG8_BAR; }
    }
    PG8_WAIT_V(0);
    if constexpr (!ALIGN_EPI) { if (wr == 0) PG8_BAR; }
    PG8_BAR;
    if constexpr (Epi::AFTER_DRAIN) { E.fused(acc, cur, wr, wc, fr, fq, lds, wid, lane); S.done(cur); }
#undef PG8_SA
#undef PG8_SB
#undef PG8_STAGE
#undef PG8_LDA
#undef PG8_LDB
#undef PG8_MMA
#undef PG8_WAIT_V
#undef PG8_WAIT_L
#undef PG8_BAR
#undef PG8_SCHED
}
}

namespace pg8 {
__device__ __forceinline__ float bf2f(unsigned short h) { return __uint_as_float(((unsigned)h) << 16); }
__device__ __forceinline__ float bflo(unsigned w) { return __uint_as_float(w << 16); }
__device__ __forceinline__ float bfhi(unsigned w) { return __uint_as_float(w & 0xffff0000u); }
__device__ __forceinline__ float sigm(float x) { return __builtin_amdgcn_rcpf(1.f + __builtin_amdgcn_exp2f(-1.4426950408889634f * x)); }
__device__ __forceinline__ u32x4 pack8(f32x4 a, f32x4 b) { u32x4 w; w.x = cvt_pk_bf16(a[0], a[1]); w.y = cvt_pk_bf16(a[2], a[3]); w.z = cvt_pk_bf16(b[0], b[1]); w.w = cvt_pk_bf16(b[2], b[3]); return w; }

struct EpiProj {
    static constexpr bool PERM = true, AFTER_DRAIN = false;
    float* CF; bf16_t* QH; float* G; bf16_t* HI; bf16_t* GS; bf16_t* GA; bf16_t* GB; const float* hg_lb;
    __device__ __forceinline__ bool keep(const Unit&) const { return false; }
    __device__ __forceinline__ void operator()(f32x4 (&acc)[2][2][4][2], const Unit& u, int wr, int wc, int fr, int fq) const {
        const int pn = u.pn; int mode, ct, ldc; float* pf = nullptr; bf16_t* ph = nullptr;
        if (pn < 7) { mode = 0; ct = pn; ldc = 1792; pf = CF; }
        else if (pn < 15) { mode = 1; ct = pn - 7; ldc = 2048; ph = QH; }
        else if (pn < 23) { mode = 2; ct = pn - 15; ldc = 2048; pf = G; }
        else if (pn < 31) { mode = 3; ct = pn - 23; ldc = 2048; ph = HI; }
        else if (pn < 39) { mode = 1; ct = pn - 31; ldc = 2048; ph = GS; }
        else if (pn < 55) { mode = 4; ct = pn - 39; ldc = 4096; ph = GA; }
        else { mode = 4; ct = pn - 55; ldc = 4096; ph = GB; }
        const int row0 = u.pm * BM + wr * 64 + fr, col0 = ct * BM + wc * 32 + 8 * fq;
        if (mode == 0) {
#pragma unroll
            for (int ai = 0; ai < 2; ++ai)
#pragma unroll
                for (int m = 0; m < 4; ++m) { float* rowp = pf + (size_t)(row0 + ai * HALF + m * 16) * ldc + col0;
#pragma unroll
                    for (int bj = 0; bj < 2; ++bj) { *(f32x4*)(rowp + bj * HALF) = acc[ai][bj][m][0]; *(f32x4*)(rowp + bj * HALF + 4) = acc[ai][bj][m][1]; } }
        } else if (mode == 2) {
#pragma unroll
            for (int bj = 0; bj < 2; ++bj) {
                f32x4 lb[2];
#pragma unroll
                for (int n = 0; n < 2; ++n) { const f32x4 l0 = *(const f32x4*)(hg_lb + col0 + bj * HALF + 4 * n), l1 = *(const f32x4*)(hg_lb + 2048 + col0 + bj * HALF + 4 * n);
#pragma unroll
                    for (int i = 0; i < 4; ++i) lb[n][i] = sigm(l0[i] - l1[i]); }
#pragma unroll
                for (int ai = 0; ai < 2; ++ai)
#pragma unroll
                    for (int m = 0; m < 4; ++m) { float* rowp = pf + (size_t)(row0 + ai * HALF + m * 16) * ldc + col0 + bj * HALF;
#pragma unroll
                        for (int n = 0; n < 2; ++n) { f32x4 v = acc[ai][bj][m][n], o;
#pragma unroll
                            for (int i = 0; i < 4; ++i) { const float f = lb[n][i] + (1.f - lb[n][i]) * sigm(v[i]); o[i] = __builtin_amdgcn_logf(f) * 0.6931471805599453f; }
                            *(f32x4*)(rowp + 4 * n) = o; } }
            }
        } else {
#pragma unroll
            for (int ai = 0; ai < 2; ++ai)
#pragma unroll
                for (int m = 0; m < 4; ++m) { bf16_t* rowp = ph + (size_t)(row0 + ai * HALF + m * 16) * ldc + col0;
#pragma unroll
                    for (int bj = 0; bj < 2; ++bj) { f32x4 v0 = acc[ai][bj][m][0], v1 = acc[ai][bj][m][1];
                        if (mode == 1) {
#pragma unroll
                            for (int i = 0; i < 4; ++i) { v0[i] = v0[i] * sigm(v0[i]); v1[i] = v1[i] * sigm(v1[i]); } }
                        else if (mode == 4) {
#pragma unroll
                            for (int i = 0; i < 4; ++i) { v0[i] = sigm(v0[i]); v1[i] = sigm(v1[i]); } }
                        *(u32x4*)(rowp + bj * HALF) = pack8(v0, v1); } }
        }
    }
};
struct EpiPlain {
    static constexpr bool PERM = true, AFTER_DRAIN = false;
    bf16_t* O; int ldc;
    __device__ __forceinline__ bool keep(const Unit&) const { return false; }
    __device__ __forceinline__ void operator()(f32x4 (&acc)[2][2][4][2], const Unit& u, int wr, int wc, int fr, int fq) const {
        const int row0 = u.pm * BM + wr * 64 + fr, col0 = u.pn * BM + wc * 32 + 8 * fq;
#pragma unroll
        for (int ai = 0; ai < 2; ++ai)
#pragma unroll
            for (int m = 0; m < 4; ++m) { bf16_t* rowp = O + (size_t)(row0 + ai * HALF + m * 16) * ldc + col0;
#pragma unroll
                for (int bj = 0; bj < 2; ++bj) *(u32x4*)(rowp + bj * HALF) = pack8(acc[ai][bj][m][0], acc[ai][bj][m][1]); }
    }
};
struct EpiQ {
    static constexpr bool PERM = true, AFTER_DRAIN = false;
    bf16_t* Q; const float* CS;
    __device__ __forceinline__ bool keep(const Unit&) const { return false; }
    __device__ __forceinline__ void operator()(f32x4 (&acc)[2][2][4][2], const Unit& u, int wr, int wc, int fr, int fq) const {
        const int row0 = u.pm * BM + wr * 64 + fr;
#pragma unroll
        for (int bj = 0; bj < 2; ++bj) {
            const int gi = u.pn * 8 + bj * 4 + wc, part = gi % 6, col0 = gi * 32 + 8 * fq;
            if (part < 4) {
#pragma unroll
                for (int ai = 0; ai < 2; ++ai)
#pragma unroll
                    for (int m = 0; m < 4; ++m) *(u32x4*)(Q + (size_t)(row0 + ai * HALF + m * 16) * 3072 + col0) = pack8(acc[ai][bj][m][0], acc[ai][bj][m][1]);
            } else {
                const int i0 = (part - 4) * 16 + 4 * fq;
#pragma unroll
                for (int ai = 0; ai < 2; ++ai)
#pragma unroll
                    for (int m = 0; m < 4; ++m) { const int row = row0 + ai * HALF + m * 16;
                        const f32x4 c = *(const f32x4*)(CS + (size_t)row * 64 + i0), s = *(const f32x4*)(CS + (size_t)row * 64 + 32 + i0);
                        const f32x4 v0 = acc[ai][bj][m][0], v1 = acc[ai][bj][m][1]; f32x4 o0, o1;
                        o0[0] = v0[0] * c[0] - v0[1] * s[0]; o0[1] = v0[0] * s[0] + v0[1] * c[0]; o0[2] = v0[2] * c[1] - v0[3] * s[1]; o0[3] = v0[2] * s[1] + v0[3] * c[1];
                        o1[0] = v1[0] * c[2] - v1[1] * s[2]; o1[1] = v1[0] * s[2] + v1[1] * c[2]; o1[2] = v1[2] * c[3] - v1[3] * s[3]; o1[3] = v1[2] * s[3] + v1[3] * c[3];
                        *(u32x4*)(Q + (size_t)row * 3072 + col0) = pack8(o0, o1); }
            }
        }
    }
};
struct EpiMerge {
    static constexpr bool PERM = true, AFTER_DRAIN = false;
    const bf16_t* GA; const bf16_t* GB; bf16_t* O;
    __device__ __forceinline__ bool keep(const Unit& u) const { return u.pm < 32; }
    __device__ __forceinline__ void operator()(f32x4 (&acc)[2][2][4][2], const Unit& u, int wr, int wc, int fr, int fq) const {
        const bool second = u.pm >= 32;
        const int row0 = (u.pm & 31) * BM + wr * 64 + fr, col0 = (u.pn & 15) * BM + wc * 32 + 8 * fq;
#pragma unroll
        for (int ai = 0; ai < 2; ++ai)
#pragma unroll
            for (int m = 0; m < 4; ++m) { const size_t off = (size_t)(row0 + ai * HALF + m * 16) * 4096 + col0;
#pragma unroll
                for (int bj = 0; bj < 2; ++bj) {
                    const u32x4 gb = *(const u32x4*)(GB + off + bj * HALF);
                    f32x4 b0, b1; b0[0] = bflo(gb.x); b0[1] = bfhi(gb.x); b0[2] = bflo(gb.y); b0[3] = bfhi(gb.y); b1[0] = bflo(gb.z); b1[1] = bfhi(gb.z); b1[2] = bflo(gb.w); b1[3] = bfhi(gb.w);
#pragma unroll
                    for (int i = 0; i < 4; ++i) { b0[i] = fmaxf(b0[i], 1e-30f); b1[i] = fmaxf(b1[i], 1e-30f); }
                    if (!second) {
                        const u32x4 ga = *(const u32x4*)(GA + off + bj * HALF);
                        f32x4 a0, a1; a0[0] = bflo(ga.x); a0[1] = bfhi(ga.x); a0[2] = bflo(ga.y); a0[3] = bfhi(ga.y); a1[0] = bflo(ga.z); a1[1] = bfhi(ga.z); a1[2] = bflo(ga.w); a1[3] = bfhi(ga.w);
#pragma unroll
                        for (int i = 0; i < 4; ++i) { acc[ai][bj][m][0][i] *= a0[i] * __builtin_amdgcn_rcpf(b0[i]); acc[ai][bj][m][1][i] *= a1[i] * __builtin_amdgcn_rcpf(b1[i]); }
                    } else {
                        *(u32x4*)(O + off + bj * HALF) = pack8(acc[ai][bj][m][0] * b0, acc[ai][bj][m][1] * b1);
                    }
                } }
    }
};
struct DualOrder {
    StaticOrder S;
    __device__ __forceinline__ bool next(int i, Unit& u) const { if (!S.next(i >> 1, u)) return false; if (i & 1) { u.pm += 32; u.pn += 16; } return true; }
    __device__ __forceinline__ void a_ready(const Unit&) const {}
    __device__ __forceinline__ void done(const Unit&) const {}
};
struct EpiMix {
    static constexpr bool PERM = false, AFTER_DRAIN = false;
    const float* X; const float* ST; const float* g; const float* b; float* Y; float alpha;
    __device__ __forceinline__ bool keep(const Unit&) const { return false; }
    __device__ __forceinline__ void operator()(f32x4 (&acc)[2][2][4][2], const Unit& u, int wr, int wc, int fr, int fq) const {
        const int row0 = u.pm * BM + wr * 64 + fr, col0 = u.pn * BM + wc * 32 + 4 * fq;
#pragma unroll
        for (int ai = 0; ai < 2; ++ai)
#pragma unroll
            for (int m = 0; m < 4; ++m) { const int row = row0 + ai * HALF + m * 16; const float mu = ST[2 * row], rs = ST[2 * row + 1]; const size_t off = (size_t)row * 4096 + col0;
#pragma unroll
                for (int bj = 0; bj < 2; ++bj)
#pragma unroll
                    for (int n = 0; n < 2; ++n) { const int cc = bj * HALF + n * 16; const f32x4 xv = *(const f32x4*)(X + off + cc), gv = *(const f32x4*)(g + col0 + cc), bv = *(const f32x4*)(b + col0 + cc);
                        *(f32x4*)(Y + off + cc) = ((xv - mu) * rs * gv + bv) * alpha + acc[ai][bj][m][n]; } }
    }
};
struct EpiSwiglu {
    static constexpr bool PERM = true, AFTER_DRAIN = false;
    bf16_t* O;
    __device__ __forceinline__ bool keep(const Unit&) const { return false; }
    __device__ __forceinline__ void operator()(f32x4 (&acc)[2][2][4][2], const Unit& u, int wr, int wc, int fr, int fq) const {
        const int row0 = u.pm * BM + wr * 64 + fr, col0 = u.pn * HALF + wc * 32 + 8 * fq;
#pragma unroll
        for (int ai = 0; ai < 2; ++ai)
#pragma unroll
            for (int m = 0; m < 4; ++m) { f32x4 o0, o1;
#pragma unroll
                for (int i = 0; i < 4; ++i) { const float g0 = acc[ai][0][m][0][i], g1 = acc[ai][0][m][1][i]; o0[i] = g0 * sigm(g0) * acc[ai][1][m][0][i]; o1[i] = g1 * sigm(g1) * acc[ai][1][m][1][i]; }
                *(u32x4*)(O + (size_t)(row0 + ai * HALF + m * 16) * 11008 + col0) = pack8(o0, o1); }
    }
};
struct EpiDown {
    static constexpr bool PERM = false, AFTER_DRAIN = false;
    const float* H1; float* Z; float alpha;
    __device__ __forceinline__ bool keep(const Unit&) const { return false; }
    __device__ __forceinline__ void operator()(f32x4 (&acc)[2][2][4][2], const Unit& u, int wr, int wc, int fr, int fq) const {
        const int row0 = u.pm * BM + wr * 64 + fr, col0 = u.pn * BM + wc * 32 + 4 * fq;
#pragma unroll
        for (int ai = 0; ai < 2; ++ai)
#pragma unroll
            for (int m = 0; m < 4; ++m) { const size_t off = (size_t)(row0 + ai * HALF + m * 16) * 4096 + col0;
#pragma unroll
                for (int bj = 0; bj < 2; ++bj)
#pragma unroll
                    for (int n = 0; n < 2; ++n) { const int cc = bj * HALF + n * 16; *(f32x4*)(Z + off + cc) = *(const f32x4*)(H1 + off + cc) * alpha + acc[ai][bj][m][n]; } }
    }
};
}

#ifndef MK_ONE_LAUNCH
#define MK_ONE_LAUNCH 1
#endif
constexpr int NWAVES = 8;
constexpr int NPHASE = 11;
constexpr int MTOK = 8192, DM = 4096, DFF = 11008, NPROJ = 18176;
constexpr float LN_EPS = 1e-5f;
constexpr float ALPHA = 1.189207115002721f;
constexpr float QSCALE = 0.07216878364870322f * 1.4426950408889634f;
constexpr size_t MiB = 1u << 20;
constexpr size_t WS_CTL = 0, CTL_ZERO_BYTES = 1 * MiB;
constexpr size_t WS_CS = 1 * MiB;
constexpr size_t WS_ST = 3 * MiB;
constexpr size_t WS_WIN = 8 * MiB;
constexpr size_t WS_Q = 8 * MiB;
constexpr size_t WS_KV = 56 * MiB;
constexpr size_t WS_CQN = 120 * MiB;
constexpr size_t WS_CKVN = 136 * MiB;
constexpr size_t WS_KROPE = 144 * MiB;
constexpr size_t WS_WUQ = 150 * MiB, WS_WUKV = 156 * MiB, WS_WAB = 160 * MiB, WS_WOUT = 192 * MiB, WS_WGU = 224 * MiB, WS_WDOWN = 396 * MiB;
constexpr size_t WS_HB = 482 * MiB;
constexpr size_t WS_CF = 546 * MiB;
constexpr size_t WS_QH = 602 * MiB, WS_G = 634 * MiB, WS_HI = 698 * MiB, WS_GS = 730 * MiB, WS_GA = 762 * MiB, WS_GB = 826 * MiB;
constexpr size_t WS_R = 546 * MiB;
constexpr size_t WS_ACT = 674 * MiB;
constexpr size_t WS_OAB = 890 * MiB;
constexpr size_t WS_END = 954 * MiB;
static_assert(WS_WIN + (size_t)NPROJ * DM * 2 <= WS_WUQ && WS_KROPE + (size_t)MTOK * 64 * 2 <= WS_WUQ, "ws map 1");
static_assert(WS_WGU + (size_t)2 * DFF * DM * 2 <= WS_WDOWN && WS_WDOWN + (size_t)DFF * DM * 2 <= WS_HB, "ws map 2");
static_assert(WS_CF + (size_t)MTOK * 1792 * 4 <= WS_QH && WS_R + (size_t)MTOK * DM * 4 <= WS_ACT && WS_ACT + (size_t)MTOK * DFF * 2 <= WS_OAB, "ws map 3");
constexpr int CW_BAR = 4096, CW_QUEUE = 2048;
constexpr int RING_OFF = 0, RING_BYTES = 131072;
constexpr int LDSCTL_OFF = RING_BYTES, MISC_OFF = LDSCTL_OFF + 320;
constexpr int LDS_BYTES = 147456;
#define GAS __attribute__((address_space(1)))
#define LAS __attribute__((address_space(3)))
typedef unsigned short bf16;
typedef unsigned v4u __attribute__((ext_vector_type(4)));
typedef float f32x4 __attribute__((ext_vector_type(4)));
typedef short bf16x8 __attribute__((ext_vector_type(8)));
typedef GAS unsigned gu32;
typedef GAS unsigned long long gu64;
#define RLX_AGENT __ATOMIC_RELAXED, __HIP_MEMORY_SCOPE_AGENT
#define LDS_WAIT() asm volatile("s_waitcnt lgkmcnt(0)" ::: "memory")
#define VM_WAIT() asm volatile("s_waitcnt vmcnt(0)" ::: "memory")
__device__ __forceinline__ unsigned long long rt() { return __builtin_amdgcn_s_memrealtime(); }
__device__ __forceinline__ unsigned f2bf(float f) { unsigned u = __builtin_bit_cast(unsigned, f); return (u + 0x7fffu + ((u >> 16) & 1u)) >> 16; }
__device__ __forceinline__ unsigned pk2(float lo, float hi) { return f2bf(lo) | (f2bf(hi) << 16); }

#define XB_TMO      128
#define XB_XCNT(j)  (256  + 64 * (j))
#define XB_XSUB(j)  (1280 + 64 * (j))
#define XB_XGEN(j)  (2304 + 64 * (j))
#define XB_TOP      3328
#define XB_TOPGEN   3392
#define XCD_BAR_WORDS 3456
#define XB_SPIN_CAP (1u << 18)

__device__ __forceinline__ unsigned xb_ld(unsigned* p)              { return __hip_atomic_load(p, __ATOMIC_RELAXED, __HIP_MEMORY_SCOPE_AGENT); }
__device__ __forceinline__ unsigned xb_add(unsigned* p, unsigned v) { return __hip_atomic_fetch_add(p, v, __ATOMIC_RELAXED, __HIP_MEMORY_SCOPE_AGENT); }
__device__ __forceinline__ unsigned xb_xcc_id() { return (unsigned)__builtin_amdgcn_s_getreg((3 << 11) | 20) & 0xFu; }
#define XB_SPIN(cond, bar) do { unsigned _sp = 0; while (cond) { __builtin_amdgcn_s_sleep(1); \
    if ((++_sp & 255u) == 0u) { if (xb_ld(&(bar)[XB_TMO])) break; if (_sp > XB_SPIN_CAP) { atomicAdd(&(bar)[XB_TMO], 1u); break; } } } } while (0)

struct XcdBarrier {
    unsigned* bar; unsigned x;
    volatile LAS unsigned* st;
};

__device__ __forceinline__ XcdBarrier xcd_barrier_post(unsigned* bar, volatile LAS unsigned* st) {
    XcdBarrier b; b.bar = bar; b.x = xb_xcc_id(); b.st = st;
    if (threadIdx.x == 0) (void)xb_add(&bar[XB_XCNT(b.x)], 1u);
    return b;
}
__device__ __forceinline__ void xcd_barrier_complete(unsigned* bar, unsigned x, unsigned& nloc, unsigned& nx) {
    const unsigned G = gridDim.x * gridDim.y * gridDim.z;
    unsigned sum, cnt, mine, sp = 0u;
    for (;;) {
        sum = 0u; cnt = 0u; mine = 0u;
#pragma unroll
        for (unsigned j = 0; j < 16; ++j) { const unsigned c = xb_ld(&bar[XB_XCNT(j)]); sum += c; cnt += (c > 0u) ? 1u : 0u; mine = (j == x) ? c : mine; }
        if (sum == G) break;
        __builtin_amdgcn_s_sleep(1);
        if ((++sp & 255u) == 0u) { if (xb_ld(&bar[XB_TMO])) break; if (sp > XB_SPIN_CAP) { atomicAdd(&bar[XB_TMO], 1u); break; } }
    }
    nloc = mine > 0u ? mine : 1u; nx = cnt > 0u ? cnt : 1u;
}

__device__ __forceinline__ void xcd_barrier(const XcdBarrier& b) {
    asm volatile("s_waitcnt vmcnt(0)" ::: "memory");
    __syncthreads();
    if (threadIdx.x == 0) {
        unsigned* bar = b.bar;
        __builtin_amdgcn_s_waitcnt(0);
        unsigned nloc = b.st[0], nx = b.st[1];
        if (nloc == 0u) { xcd_barrier_complete(bar, b.x, nloc, nx); b.st[0] = nloc; b.st[1] = nx; }
        const unsigned old = xb_add(&bar[XB_XSUB(b.x)], 1u);
        const unsigned gen = old / nloc;
        if (old + 1u == (gen + 1u) * nloc) {
            __builtin_amdgcn_fence(__ATOMIC_RELEASE, "agent");
            asm volatile("s_waitcnt vmcnt(0)" ::: "memory");
            const unsigned og = xb_add(&bar[XB_TOP], 1u);
            const unsigned tg = og / nx;
            if (og + 1u == (tg + 1u) * nx) xb_add(&bar[XB_TOPGEN], 1u);
            else XB_SPIN(xb_ld(&bar[XB_TOPGEN]) == tg, bar);
            __builtin_amdgcn_fence(__ATOMIC_ACQUIRE, "agent");
            xb_add(&bar[XB_XGEN(b.x)], 1u);
            asm volatile("s_waitcnt vmcnt(0)" ::: "memory");
        } else {
            XB_SPIN(xb_ld(&bar[XB_XGEN(b.x)]) == gen, bar);
            __builtin_amdgcn_fence(__ATOMIC_ACQUIRE, "agent");
            asm volatile("s_waitcnt vmcnt(0)" ::: "memory");
        }
    }
    __syncthreads();
}

namespace att {
typedef float f32x16 __attribute__((ext_vector_type(16)));
typedef short s16x4 __attribute__((ext_vector_type(4)));
typedef short bf16x8 __attribute__((ext_vector_type(8)));
typedef unsigned u32x4 __attribute__((ext_vector_type(4)));
typedef float f32x2_t __attribute__((ext_vector_type(2))); typedef __bf16 bf16x2_t __attribute__((ext_vector_type(2)));
constexpr int KP = 400, VP = 320, KBUF = 64 * KP, VBUF = 64 * VP, LDS_NEED = 2 * KBUF + 2 * VBUF;
__device__ __forceinline__ unsigned cvtpk(float lo, float hi) { f32x2_t v = {lo, hi}; bf16x2_t b = __builtin_convertvector(v, bf16x2_t); return __builtin_bit_cast(unsigned, b); }
__device__ __forceinline__ s16x4 vtr(const LAS unsigned char* p) { return __builtin_bit_cast(s16x4, __builtin_amdgcn_ds_read_tr16_b64_v4i16((LAS s16x4*)p)); }
__device__ __forceinline__ void attn_unit(LAS unsigned char* lds, const bf16* Q, const bf16* KV, const bf16* KROPE, bf16* OA, int b, int h, int qb, int tid) {
    const int lane = tid & 63, wid = __builtin_amdgcn_readfirstlane(tid >> 6), r32 = lane & 31, hh = lane >> 5;
    const size_t rowbase = (size_t)b * 2048;
    const int q0 = qb * 256 + wid * 32;
    bf16x8 qf[12];
    { const bf16* qrow = Q + (rowbase + q0 + r32) * 3072 + h * 192 + hh * 8;
#pragma unroll
      for (int d0 = 0; d0 < 12; ++d0) qf[d0] = *(const GAS bf16x8*)(qrow + d0 * 16); }
    const int NT = 4 * (qb + 1), myNT = 4 * qb + (wid >> 1) + 1;
    const GAS unsigned char* kvb = (const GAS unsigned char*)KV; const long krope_delta = (const unsigned char*)KROPE - (const unsigned char*)KV;
    unsigned ksrc[3], kstr[3]; int kdst[3];
#pragma unroll
    for (int i = 0; i < 3; ++i) { const int c = tid + 512 * i, row = c / 24, cc = c - row * 24;
        if (cc < 16) { ksrc[i] = (unsigned)(((rowbase + row) * 4096 + h * 256 + cc * 8) * 2); kstr[i] = 64u * 4096u * 2u; }
        else { ksrc[i] = (unsigned)(krope_delta + (long)((rowbase + row) * 64 + (cc - 16) * 8) * 2); kstr[i] = 64u * 64u * 2u; }
        kdst[i] = row * KP + cc * 16; }
    unsigned vsrc[2]; int vdst[2];
#pragma unroll
    for (int i = 0; i < 2; ++i) { const int c = tid + 512 * i, row = c >> 4, cc = c & 15; vsrc[i] = (unsigned)(((rowbase + row) * 4096 + h * 256 + 128 + cc * 8) * 2); vdst[i] = row * VP + cc * 16; }
    u32x4 kreg[3], vreg[2];
#define ATT_LOAD(t) do { _Pragma("unroll") for (int i = 0; i < 3; ++i) kreg[i] = *(const GAS u32x4*)(kvb + (ksrc[i] + (unsigned)(t) * kstr[i])); \
                         _Pragma("unroll") for (int i = 0; i < 2; ++i) vreg[i] = *(const GAS u32x4*)(kvb + (vsrc[i] + (unsigned)(t) * (64u * 4096u * 2u))); } while (0)
#define ATT_STORE(buf) do { _Pragma("unroll") for (int i = 0; i < 3; ++i) *(LAS u32x4*)(lds + (buf) * KBUF + kdst[i]) = kreg[i]; \
                            _Pragma("unroll") for (int i = 0; i < 2; ++i) *(LAS u32x4*)(lds + 2 * KBUF + (buf) * VBUF + vdst[i]) = vreg[i]; } while (0)
    __syncthreads();
    ATT_LOAD(0); ATT_STORE(0);
    __syncthreads();
    f32x16 o[4];
#pragma unroll
    for (int d = 0; d < 4; ++d)
#pragma unroll
        for (int r = 0; r < 16; ++r) o[d][r] = 0.f;
    float mrun = -1e30f, lrun = 0.f;
    const int koff = r32 * KP + hh * 16;
    const int voff = (4 * hh + ((lane & 15) >> 2)) * VP + ((lane >> 4) & 1) * 32 + (lane & 3) * 8;
    for (int t = 0; t < NT; ++t) {
        const int buf = t & 1;
        if (t + 1 < NT) ATT_LOAD(t + 1);
        if (t < myNT) {
            const LAS unsigned char* Kb = lds + buf * KBUF + koff; const LAS unsigned char* Vb = lds + 2 * KBUF + buf * VBUF + voff;
            f32x16 p0, p1;
#pragma unroll
            for (int r = 0; r < 16; ++r) { p0[r] = 0.f; p1[r] = 0.f; }
#pragma unroll
            for (int d0 = 0; d0 < 12; ++d0) {
                const bf16x8 a0 = *(const LAS bf16x8*)(Kb + d0 * 32), a1 = *(const LAS bf16x8*)(Kb + 32 * KP + d0 * 32);
                p0 = __builtin_amdgcn_mfma_f32_32x32x16_bf16(a0, qf[d0], p0, 0, 0, 0);
                p1 = __builtin_amdgcn_mfma_f32_32x32x16_bf16(a1, qf[d0], p1, 0, 0, 0);
                if ((d0 & 3) == 3) __builtin_amdgcn_sched_barrier(0);
            }
            float mt = fmaxf(p0[0], p1[0]);
#pragma unroll
            for (int r = 1; r < 16; ++r) mt = fmaxf(mt, fmaxf(p0[r], p1[r]));
            mt = fmaxf(mt, __shfl_xor(mt, 32));
            const float mn = fmaxf(mrun, mt), corr = __builtin_amdgcn_exp2f(mrun - mn); mrun = mn;
            float rs = 0.f;
#pragma unroll
            for (int r = 0; r < 16; ++r) { p0[r] = __builtin_amdgcn_exp2f(p0[r] - mn); p1[r] = __builtin_amdgcn_exp2f(p1[r] - mn); rs += p0[r] + p1[r]; }
            lrun = lrun * corr + rs;
#pragma unroll
            for (int d = 0; d < 4; ++d)
#pragma unroll
                for (int r = 0; r < 16; ++r) o[d][r] *= corr;
#pragma unroll
            for (int ks = 0; ks < 4; ++ks) {
                u32x4 pw;
                if (ks == 0) { pw.x = cvtpk(p0[0], p0[1]); pw.y = cvtpk(p0[2], p0[3]); pw.z = cvtpk(p0[4], p0[5]); pw.w = cvtpk(p0[6], p0[7]); }
                else if (ks == 1) { pw.x = cvtpk(p0[8], p0[9]); pw.y = cvtpk(p0[10], p0[11]); pw.z = cvtpk(p0[12], p0[13]); pw.w = cvtpk(p0[14], p0[15]); }
                else if (ks == 2) { pw.x = cvtpk(p1[0], p1[1]); pw.y = cvtpk(p1[2], p1[3]); pw.z = cvtpk(p1[4], p1[5]); pw.w = cvtpk(p1[6], p1[7]); }
                else { pw.x = cvtpk(p1[8], p1[9]); pw.y = cvtpk(p1[10], p1[11]); pw.z = cvtpk(p1[12], p1[13]); pw.w = cvtpk(p1[14], p1[15]); }
                const bf16x8 pf = __builtin_bit_cast(bf16x8, pw);
#pragma unroll
                for (int d = 0; d < 4; ++d) {
                    const s16x4 lo = vtr(Vb + (16 * ks) * VP + d * 64), hi = vtr(Vb + (16 * ks + 8) * VP + d * 64);
                    const bf16x8 vf = {lo[0], lo[1], lo[2], lo[3], hi[0], hi[1], hi[2], hi[3]};
                    o[d] = __builtin_amdgcn_mfma_f32_32x32x16_bf16(vf, pf, o[d], 0, 0, 0);
                }
                __builtin_amdgcn_sched_barrier(0);
            }
        }
        if (t + 1 < NT) ATT_STORE(buf ^ 1);
        __syncthreads();
    }
    lrun += __shfl_xor(lrun, 32);
    const float il = 1.f / lrun;
    bf16* orow = OA + (rowbase + q0 + r32) * 2048 + h * 128 + 4 * hh;
#pragma unroll
    for (int d = 0; d < 4; ++d)
#pragma unroll
        for (int g = 0; g < 4; ++g) {
            const unsigned w0 = cvtpk(o[d][4 * g] * il, o[d][4 * g + 1] * il), w1 = cvtpk(o[d][4 * g + 2] * il, o[d][4 * g + 3] * il);
            *(GAS unsigned long long*)(orow + d * 32 + 8 * g) = (unsigned long long)w0 | ((unsigned long long)w1 << 32);
        }
#undef ATT_LOAD
#undef ATT_STORE
}
}

namespace hg {
typedef float f32x4 __attribute__((ext_vector_type(4)));
typedef short bf16x8 __attribute__((ext_vector_type(8)));
typedef unsigned u32x4 __attribute__((ext_vector_type(4)));
constexpr int PQ = 272, PS = 144;
constexpr int O_QT = 0, O_KT = 64 * PQ, O_KH = 2 * 64 * PQ, O_VT = O_KH + 128 * PS, O_AS = O_VT + 128 * PS, O_ST = O_AS + 64 * PS, O_TOT = O_ST + 128 * PQ, O_D = O_TOT + 2048, O_XS = O_D + 512, LDS_NEED = O_XS + 512;
__device__ __forceinline__ unsigned cvtpk(float lo, float hi) { return att::cvtpk(lo, hi); }
__device__ __forceinline__ unsigned short cvt1(float v) { return (unsigned short)(att::cvtpk(v, 0.f) & 0xffffu); }
#define HG_MFMA(a, b, c) __builtin_amdgcn_mfma_f32_16x16x32_bf16((a), (b), (c), 0, 0, 0)
__device__ __forceinline__ void hgrn_task(LAS unsigned char* lds, const float* GL, const bf16* QH, const bf16* HI, const bf16* GS, const float* gn, bf16* OB, int b, int h, int tid) {
    const int lane = tid & 63, w = __builtin_amdgcn_readfirstlane(tid >> 6), l15 = lane & 15, q4 = lane >> 4;
    const int seg = tid >> 7, kk = tid & 127, tt = w >> 1, vh = w & 1;
    LAS float* TOT = (LAS float*)(lds + O_TOT); LAS float* DD = (LAS float*)(lds + O_D); LAS float* XS = (LAS float*)(lds + O_XS);
    __syncthreads();
    for (int i = tid; i < 128 * PQ / 16; i += 512) ((LAS u32x4*)(lds + O_ST))[i] = (u32x4){0u, 0u, 0u, 0u};
    f32x4 Sacc[8];
#pragma unroll
    for (int i = 0; i < 8; ++i) Sacc[i] = (f32x4){0.f, 0.f, 0.f, 0.f};
    const size_t base = (size_t)b * 2048 * 2048 + h * 128;
    float gpre[16]; unsigned short qpre[16], vpre[16];
#define HG_LOADC(c) do { const size_t o_ = base + (size_t)((c) * 64 + seg * 16) * 2048 + kk; \
        _Pragma("unroll") for (int i = 0; i < 16; ++i) { gpre[i] = GL[o_ + (size_t)i * 2048]; qpre[i] = QH[o_ + (size_t)i * 2048]; vpre[i] = HI[o_ + (size_t)i * 2048]; } } while (0)
    HG_LOADC(0);
    float gnv[4];
#pragma unroll
    for (int vt = 0; vt < 4; ++vt) gnv[vt] = gn[16 * (4 * vh + vt) + l15];
    for (int c = 0; c < 32; ++c) {
        float cs[16], kin[16], qf[16];
        { float run = 0.f;
#pragma unroll
          for (int i = 0; i < 16; ++i) { run += gpre[i]; cs[i] = run; kin[i] = 1.f - __expf(gpre[i]); qf[i] = __uint_as_float(((unsigned)qpre[i]) << 16); } }
        TOT[seg * 128 + kk] = cs[15];
        { u32x4 v0, v1;
          v0.x = (unsigned)vpre[0] | ((unsigned)vpre[1] << 16); v0.y = (unsigned)vpre[2] | ((unsigned)vpre[3] << 16); v0.z = (unsigned)vpre[4] | ((unsigned)vpre[5] << 16); v0.w = (unsigned)vpre[6] | ((unsigned)vpre[7] << 16);
          v1.x = (unsigned)vpre[8] | ((unsigned)vpre[9] << 16); v1.y = (unsigned)vpre[10] | ((unsigned)vpre[11] << 16); v1.z = (unsigned)vpre[12] | ((unsigned)vpre[13] << 16); v1.w = (unsigned)vpre[14] | ((unsigned)vpre[15] << 16);
          *(LAS u32x4*)(lds + O_VT + kk * PS + seg * 32) = v0; *(LAS u32x4*)(lds + O_VT + kk * PS + seg * 32 + 16) = v1; }
        __syncthreads();
        { const float t0 = TOT[kk], t1 = TOT[128 + kk], t2 = TOT[256 + kk], t3 = TOT[384 + kk];
          const float pre = (seg > 0 ? t0 : 0.f) + (seg > 1 ? t1 : 0.f) + (seg > 2 ? t2 : 0.f), bl = (t0 + t1) + (t2 + t3);
          unsigned short kh[16];
#pragma unroll
          for (int i = 0; i < 16; ++i) { const float bb = fmaxf(pre + cs[i], -85.f); const float e = __expf(bb), ei = __expf(-bb), eh = __expf(fminf(bl - bb, 0.f));
              *(LAS unsigned short*)(lds + O_QT + (seg * 16 + i) * PQ + kk * 2) = cvt1(qf[i] * e);
              *(LAS unsigned short*)(lds + O_KT + (seg * 16 + i) * PQ + kk * 2) = cvt1(kin[i] * ei);
              kh[i] = cvt1(kin[i] * eh); }
          u32x4 k0, k1;
          k0.x = (unsigned)kh[0] | ((unsigned)kh[1] << 16); k0.y = (unsigned)kh[2] | ((unsigned)kh[3] << 16); k0.z = (unsigned)kh[4] | ((unsigned)kh[5] << 16); k0.w = (unsigned)kh[6] | ((unsigned)kh[7] << 16);
          k1.x = (unsigned)kh[8] | ((unsigned)kh[9] << 16); k1.y = (unsigned)kh[10] | ((unsigned)kh[11] << 16); k1.z = (unsigned)kh[12] | ((unsigned)kh[13] << 16); k1.w = (unsigned)kh[14] | ((unsigned)kh[15] << 16);
          *(LAS u32x4*)(lds + O_KH + kk * PS + seg * 32) = k0; *(LAS u32x4*)(lds + O_KH + kk * PS + seg * 32 + 16) = k1;
          if (seg == 0) DD[kk] = __expf(fmaxf(bl, -85.f)); }
        __syncthreads();
        unsigned short gsv[4][4];
        { const size_t o_ = base + (size_t)(c * 64 + 16 * tt + 4 * q4) * 2048 + 64 * vh + l15;
#pragma unroll
          for (int vt = 0; vt < 4; ++vt)
#pragma unroll
              for (int r = 0; r < 4; ++r) gsv[vt][r] = GS[o_ + (size_t)r * 2048 + 16 * vt]; }
        if (c + 1 < 32) HG_LOADC(c + 1);
        bf16x8 aq[4];
#pragma unroll
        for (int ks = 0; ks < 4; ++ks) aq[ks] = *(const LAS bf16x8*)(lds + O_QT + (16 * tt + l15) * PQ + ks * 64 + q4 * 16);
#pragma unroll
        for (int j = 0; j < 2; ++j) {
            const int st = 2 * vh + j;
            f32x4 a = (f32x4){0.f, 0.f, 0.f, 0.f};
            if (st <= tt) {
#pragma unroll
                for (int ks = 0; ks < 4; ++ks) a = HG_MFMA(aq[ks], *(const LAS bf16x8*)(lds + O_KT + (16 * st + l15) * PQ + ks * 64 + q4 * 16), a);
                if (st == tt) {
#pragma unroll
                    for (int r = 0; r < 4; ++r) if (l15 > 4 * q4 + r) a[r] = 0.f;
                }
            }
#pragma unroll
            for (int r = 0; r < 4; ++r) *(LAS unsigned short*)(lds + O_AS + (16 * tt + 4 * q4 + r) * PS + (16 * st + l15) * 2) = cvt1(a[r]);
        }
        f32x4 oacc[4];
#pragma unroll
        for (int vt = 0; vt < 4; ++vt) { oacc[vt] = (f32x4){0.f, 0.f, 0.f, 0.f};
#pragma unroll
            for (int ks = 0; ks < 4; ++ks) oacc[vt] = HG_MFMA(aq[ks], *(const LAS bf16x8*)(lds + O_ST + (16 * (4 * vh + vt) + l15) * PQ + ks * 64 + q4 * 16), oacc[vt]); }
        __syncthreads();
#pragma unroll
        for (int ks = 0; ks < 2; ++ks) { const bf16x8 aa = *(const LAS bf16x8*)(lds + O_AS + (16 * tt + l15) * PS + ks * 64 + q4 * 16);
#pragma unroll
            for (int vt = 0; vt < 4; ++vt) oacc[vt] = HG_MFMA(aa, *(const LAS bf16x8*)(lds + O_VT + (16 * (4 * vh + vt) + l15) * PS + ks * 64 + q4 * 16), oacc[vt]); }
        { const bf16x8 av0 = *(const LAS bf16x8*)(lds + O_VT + (16 * w + l15) * PS + q4 * 16), av1 = *(const LAS bf16x8*)(lds + O_VT + (16 * w + l15) * PS + 64 + q4 * 16);
#pragma unroll
          for (int kt = 0; kt < 8; ++kt) { const float d = DD[16 * kt + l15]; Sacc[kt] = Sacc[kt] * d;
              Sacc[kt] = HG_MFMA(av0, *(const LAS bf16x8*)(lds + O_KH + (16 * kt + l15) * PS + q4 * 16), Sacc[kt]);
              Sacc[kt] = HG_MFMA(av1, *(const LAS bf16x8*)(lds + O_KH + (16 * kt + l15) * PS + 64 + q4 * 16), Sacc[kt]);
#pragma unroll
              for (int r = 0; r < 4; ++r) *(LAS unsigned short*)(lds + O_ST + (16 * w + 4 * q4 + r) * PQ + (16 * kt + l15) * 2) = cvt1(Sacc[kt][r]); } }
        { float ss[4];
#pragma unroll
          for (int r = 0; r < 4; ++r) { ss[r] = (oacc[0][r] * oacc[0][r] + oacc[1][r] * oacc[1][r]) + (oacc[2][r] * oacc[2][r] + oacc[3][r] * oacc[3][r]);
              ss[r] += __shfl_xor(ss[r], 1); ss[r] += __shfl_xor(ss[r], 2); ss[r] += __shfl_xor(ss[r], 4); ss[r] += __shfl_xor(ss[r], 8); }
          if (l15 == 0) {
#pragma unroll
              for (int r = 0; r < 4; ++r) XS[(16 * tt + 4 * q4 + r) * 2 + vh] = ss[r]; } }
        __syncthreads();
        { const size_t o_ = base + (size_t)(c * 64 + 16 * tt + 4 * q4) * 2048 + 64 * vh + l15;
#pragma unroll
          for (int r = 0; r < 4; ++r) { const int t = 16 * tt + 4 * q4 + r; const float rs = 1.f / sqrtf((XS[2 * t] + XS[2 * t + 1]) * (1.f / 128.f) + LN_EPS);
#pragma unroll
              for (int vt = 0; vt < 4; ++vt) OB[o_ + (size_t)r * 2048 + 16 * vt] = cvt1(oacc[vt][r] * rs * gnv[vt] * __uint_as_float(((unsigned)gsv[vt][r]) << 16)); } }
    }
#undef HG_LOADC
}
#undef HG_MFMA
}

struct Frame {
    LAS unsigned char* lds;
    volatile LAS unsigned* MISC;
    gu32* ctl;
    int tid, lane, wave, vcu, G;
};
__device__ __forceinline__ float wave_sum(float v) {
#pragma unroll
    for (int o = 1; o < 64; o <<= 1) v += __shfl_xor(v, o);
    return v;
}
__device__ __forceinline__ float bf2f(bf16 h) { return __uint_as_float(((unsigned)h) << 16); }
__device__ __forceinline__ float bflo(unsigned w) { return __uint_as_float(w << 16); }
__device__ __forceinline__ float bfhi(unsigned w) { return __uint_as_float(w & 0xffff0000u); }

template <class RowMap>
__device__ __forceinline__ void p0_transpose_item(const float* W, int K, int N, bf16* WT, const RowMap rm, float scale, LAS float* scr, int item, int lane) {
    const int nblk = N / 32, kb = item / nblk, nb = item % nblk, k0 = 64 * kb, n0 = 32 * nb;
#pragma unroll 8
    for (int i = 0; i < 32; ++i) { const int kk = 2 * i + (lane >> 5); scr[kk * 33 + (lane & 31)] = W[(size_t)(k0 + kk) * N + n0 + (lane & 31)]; }
    LDS_WAIT(); asm volatile("" ::: "memory");
    const int c = lane & 7;
#pragma unroll
    for (int j = 0; j < 4; ++j) { const int n = (lane >> 3) + 8 * j; const LAS float* s = scr + (8 * c) * 33 + n;
        v4u o; o.x = pk2(s[0 * 33] * scale, s[1 * 33] * scale); o.y = pk2(s[2 * 33] * scale, s[3 * 33] * scale); o.z = pk2(s[4 * 33] * scale, s[5 * 33] * scale); o.w = pk2(s[6 * 33] * scale, s[7 * 33] * scale);
        *(GAS v4u*)(WT + (size_t)rm(n0 + n) * K + k0 + 8 * c) = o; }
    LDS_WAIT(); asm volatile("" ::: "memory");
}
struct RmId { int off; __device__ __forceinline__ int operator()(int n) const { return n + off; } };
struct RmWin { __device__ __forceinline__ int operator()(int n) const { if (n < 1536) return n; if (n < 1600) { const int i = n - 1536; return 1536 + ((i & 31) << 1) + (i >> 5); } return n + 192; } };
struct RmUq { __device__ __forceinline__ int operator()(int n) const { const int hd = n / 192, w = n - hd * 192; if (w < 128) return n; const int i = w - 128; return hd * 192 + 128 + ((i & 31) << 1) + (i >> 5); } };
struct RmGu { int up; __device__ __forceinline__ int operator()(int n) const { return ((n >> 7) << 8) + (n & 127) + up; } };

template <bool WF32, bool WBF, bool WST>
__device__ __forceinline__ void ln_row(const float* xrow, const float* g, const float* b, float* of, bf16* ob, float* st, int lane) {
    const GAS f32x4* xr = (const GAS f32x4*)xrow + lane;
    f32x4 v[16]; float s = 0.f;
#pragma unroll
    for (int j = 0; j < 16; ++j) { v[j] = xr[64 * j]; s += (v[j].x + v[j].y) + (v[j].z + v[j].w); }
    const float mean = wave_sum(s) * (1.f / 4096.f); float s2 = 0.f;
#pragma unroll
    for (int j = 0; j < 16; ++j) { v[j] = v[j] - mean; s2 += (v[j].x * v[j].x + v[j].y * v[j].y) + (v[j].z * v[j].z + v[j].w * v[j].w); }
    const float rstd = 1.f / sqrtf(wave_sum(s2) * (1.f / 4096.f) + LN_EPS);
    if (WST) { if (lane == 0) { st[0] = mean; st[1] = rstd; } }
    const GAS f32x4* gr = (const GAS f32x4*)g + lane; const GAS f32x4* br = (const GAS f32x4*)b + lane;
#pragma unroll
    for (int j = 0; j < 16; ++j) { const f32x4 o = v[j] * rstd * gr[64 * j] + br[64 * j];
        if (WF32) ((GAS f32x4*)of)[lane + 64 * j] = o;
        if (WBF) ((GAS unsigned long long*)ob)[lane + 64 * j] = (unsigned long long)pk2(o.x, o.y) | ((unsigned long long)pk2(o.z, o.w) << 32); }
}

struct Args { const void* in[21]; float* out; unsigned char* ws; int ph_lo, ph_hi; };
__global__ void __launch_bounds__(NWAVES * 64, 2) mega_fwd(Args args) {
    extern __shared__ __attribute__((aligned(16))) unsigned char lds[];
    Frame F;
    F.lds = (LAS unsigned char*)lds;
    F.MISC = (volatile LAS unsigned*)(F.lds + MISC_OFF);
    F.tid = threadIdx.x; F.lane = F.tid & 63; F.wave = __builtin_amdgcn_readfirstlane(F.tid >> 6);
    F.G = gridDim.x; { const int bx = blockIdx.x; F.vcu = (F.G % 8 == 0) ? (bx % 8) * (F.G / 8) + bx / 8 : bx; }
    unsigned char* ws = args.ws;
    F.ctl = (gu32*)(ws + WS_CTL);
    const float* x = (const float*)args.in[0]; const int* positions = (const int*)args.in[1];
    const float* ln_in_g = (const float*)args.in[2]; const float* ln_in_b = (const float*)args.in[3];
    const float* w_in = (const float*)args.in[4]; const float* q_norm_g = (const float*)args.in[5]; const float* w_uq = (const float*)args.in[6];
    const float* kv_norm_g = (const float*)args.in[7]; const float* w_ukv = (const float*)args.in[8]; const float* hg_lb = (const float*)args.in[9];
    const float* hg_norm_g = (const float*)args.in[10]; const float* w_a = (const float*)args.in[11]; const float* w_b = (const float*)args.in[12];
    const float* w_out = (const float*)args.in[13]; const float* ln1_g = (const float*)args.in[14]; const float* ln1_b = (const float*)args.in[15];
    const float* w_gate = (const float*)args.in[16]; const float* w_up = (const float*)args.in[17]; const float* w_down = (const float*)args.in[18];
    const float* ln2_g = (const float*)args.in[19]; const float* ln2_b = (const float*)args.in[20];
    float* out = args.out;
    bf16* Wt_in = (bf16*)(ws + WS_WIN); bf16* Wt_uq = (bf16*)(ws + WS_WUQ); bf16* Wt_ukv = (bf16*)(ws + WS_WUKV); bf16* Wt_ab = (bf16*)(ws + WS_WAB);
    bf16* Wt_out = (bf16*)(ws + WS_WOUT); bf16* Wt_gu = (bf16*)(ws + WS_WGU); bf16* Wt_down = (bf16*)(ws + WS_WDOWN);
    bf16* HB = (bf16*)(ws + WS_HB); float* CS = (float*)(ws + WS_CS); float* ST = (float*)(ws + WS_ST);
    float* CF = (float*)(ws + WS_CF); bf16* QH = (bf16*)(ws + WS_QH); float* GL = (float*)(ws + WS_G); bf16* HI = (bf16*)(ws + WS_HI); bf16* GS = (bf16*)(ws + WS_GS);
    bf16* GA = (bf16*)(ws + WS_GA); bf16* GB = (bf16*)(ws + WS_GB);
    bf16* Q = (bf16*)(ws + WS_Q); bf16* KV = (bf16*)(ws + WS_KV); bf16* CQN = (bf16*)(ws + WS_CQN); bf16* CKVN = (bf16*)(ws + WS_CKVN); bf16* KROPE = (bf16*)(ws + WS_KROPE);
    bf16* OAB = (bf16*)(ws + WS_OAB); bf16* MERGED = (bf16*)(ws + WS_KV); float* R = (float*)(ws + WS_R); bf16* ACT = (bf16*)(ws + WS_ACT);

    for (int u = F.tid; u < (LDS_BYTES - LDSCTL_OFF) / 4; u += NWAVES * 64) ((LAS unsigned*)(F.lds + LDSCTL_OFF))[u] = 0u;
    __syncthreads();
#if MK_ONE_LAUNCH
    XcdBarrier bar = xcd_barrier_post((unsigned*)(F.ctl + CW_BAR), F.MISC + 8);
#define GRID_BAR() xcd_barrier(bar)
#else
#define GRID_BAR() do {} while (0)
#endif
    const int lo = args.ph_lo, hi = args.ph_hi;
#define IN(k) (lo <= (k) && (k) < hi)
#define BOTH(k) (IN(k) && IN((k) + 1))
    const int gw = F.vcu * NWAVES + F.wave, NGW = F.G * NWAVES;
    const int gt = blockIdx.x * (NWAVES * 64) + F.tid, NGT = F.G * NWAVES * 64;

    if (IN(0)) {
        LAS float* scr = (LAS float*)(F.lds + RING_OFF + F.wave * 16384);
        constexpr int I_IN = (DM / 64) * (17984 / 32), I_UQ = (1024 / 64) * (3072 / 32), I_UKV = (512 / 64) * (4096 / 32), I_A = (2048 / 64) * (4096 / 32), I_B = I_A,
                      I_OUT = (4096 / 64) * (4096 / 32), I_G = (4096 / 64) * (DFF / 32), I_U = I_G, I_D = (DFF / 64) * (4096 / 32);
        constexpr int NITEMS = I_IN + I_UQ + I_UKV + I_A + I_B + I_OUT + I_G + I_U + I_D;
        for (int it = gw; it < NITEMS; it += NGW) {
            int r = it;
            if (r < I_IN) { p0_transpose_item(w_in, DM, 17984, Wt_in, RmWin{}, 1.f, scr, r, F.lane); continue; } r -= I_IN;
            if (r < I_UQ) { p0_transpose_item(w_uq, 1024, 3072, Wt_uq, RmUq{}, QSCALE, scr, r, F.lane); continue; } r -= I_UQ;
            if (r < I_UKV) { p0_transpose_item(w_ukv, 512, 4096, Wt_ukv, RmId{0}, 1.f, scr, r, F.lane); continue; } r -= I_UKV;
            if (r < I_A) { p0_transpose_item(w_a, 2048, 4096, Wt_ab, RmId{0}, 1.f, scr, r, F.lane); continue; } r -= I_A;
            if (r < I_B) { p0_transpose_item(w_b, 2048, 4096, Wt_ab, RmId{4096}, 1.f, scr, r, F.lane); continue; } r -= I_B;
            if (r < I_OUT) { p0_transpose_item(w_out, 4096, 4096, Wt_out, RmId{0}, 1.f, scr, r, F.lane); continue; } r -= I_OUT;
            if (r < I_G) { p0_transpose_item(w_gate, 4096, DFF, Wt_gu, RmGu{0}, 1.f, scr, r, F.lane); continue; } r -= I_G;
            if (r < I_U) { p0_transpose_item(w_up, 4096, DFF, Wt_gu, RmGu{128}, 1.f, scr, r, F.lane); continue; } r -= I_U;
            p0_transpose_item(w_down, DFF, 4096, Wt_down, RmId{0}, 1.f, scr, r, F.lane);
        }
        for (int i = gt; i < 192 * DM / 8; i += NGT) ((GAS v4u*)(Wt_in + (size_t)1600 * DM))[i] = (v4u){0u, 0u, 0u, 0u};
        for (int m = gw; m < MTOK; m += NGW) ln_row<false, true, true>(x + (size_t)m * DM, ln_in_g, ln_in_b, nullptr, HB + (size_t)m * DM, ST + 2 * m, F.lane);
        for (int i = gt; i < MTOK * 32; i += NGT) { const int row = i >> 5, k = i & 31;
            const float inv = exp2f(-(float)k * (13.287712379549449f / 32.f)); const float ang = (float)positions[row] * inv;
            CS[(size_t)row * 64 + k] = cosf(ang); CS[(size_t)row * 64 + 32 + k] = sinf(ang); }
        if (BOTH(0)) GRID_BAR();
    }
    if (IN(1)) {
        pg8::Gemm g{HB, Wt_in, MTOK, NPROJ, DM}; pg8::StaticOrder S; S.init(MTOK, NPROJ, F.G, (int)blockIdx.x);
        pg8::EpiProj E{CF, QH, GL, HI, GS, GA, GB, hg_lb};
        pg8::gemm_phase<pg8::EpiProj, pg8::StaticOrder, true, true>(F.lds + RING_OFF, g, S, E);
        if (BOTH(1)) GRID_BAR();
    }
    if (IN(2)) {
        for (int m = gw; m < MTOK; m += NGW) {
            const float* cf = CF + (size_t)m * 1792;
            { const GAS f32x4* p = (const GAS f32x4*)cf + F.lane; f32x4 v[4]; float s = 0.f;
#pragma unroll
              for (int j = 0; j < 4; ++j) { v[j] = p[64 * j]; s += (v[j].x * v[j].x + v[j].y * v[j].y) + (v[j].z * v[j].z + v[j].w * v[j].w); }
              const float rs = 1.f / sqrtf(wave_sum(s) * (1.f / 1024.f) + LN_EPS);
#pragma unroll
              for (int j = 0; j < 4; ++j) { const f32x4 gg = ((const GAS f32x4*)q_norm_g)[F.lane + 64 * j]; const f32x4 o = v[j] * rs * gg;
                  ((GAS unsigned long long*)(CQN + (size_t)m * 1024))[F.lane + 64 * j] = (unsigned long long)pk2(o.x, o.y) | ((unsigned long long)pk2(o.z, o.w) << 32); } }
            { const GAS f32x4* p = (const GAS f32x4*)(cf + 1024) + F.lane; f32x4 v[2]; float s = 0.f;
#pragma unroll
              for (int j = 0; j < 2; ++j) { v[j] = p[64 * j]; s += (v[j].x * v[j].x + v[j].y * v[j].y) + (v[j].z * v[j].z + v[j].w * v[j].w); }
              const float rs = 1.f / sqrtf(wave_sum(s) * (1.f / 512.f) + LN_EPS);
#pragma unroll
              for (int j = 0; j < 2; ++j) { const f32x4 gg = ((const GAS f32x4*)kv_norm_g)[F.lane + 64 * j]; const f32x4 o = v[j] * rs * gg;
                  ((GAS unsigned long long*)(CKVN + (size_t)m * 512))[F.lane + 64 * j] = (unsigned long long)pk2(o.x, o.y) | ((unsigned long long)pk2(o.z, o.w) << 32); } }
            if (F.lane < 32) { const float x1 = cf[1536 + 2 * F.lane], x2 = cf[1536 + 2 * F.lane + 1], c = CS[(size_t)m * 64 + F.lane], s = CS[(size_t)m * 64 + 32 + F.lane];
                ((GAS unsigned*)(KROPE + (size_t)m * 64))[F.lane] = pk2(x1 * c - x2 * s, x1 * s + x2 * c); }
        }
        if (BOTH(2)) GRID_BAR();
    }
    if (IN(3)) {
        { pg8::Gemm g{CQN, Wt_uq, MTOK, 3072, 1024}; pg8::StaticOrder S; S.init(MTOK, 3072, F.G, (int)blockIdx.x);
          pg8::EpiQ E{Q, CS};
          pg8::gemm_phase<pg8::EpiQ, pg8::StaticOrder, true, true>(F.lds + RING_OFF, g, S, E); }
        { pg8::Gemm g{CKVN, Wt_ukv, MTOK, 4096, 512}; pg8::StaticOrder S; S.init(MTOK, 4096, F.G, (int)blockIdx.x);
          pg8::EpiPlain E{KV, 4096};
          pg8::gemm_phase<pg8::EpiPlain, pg8::StaticOrder, true, true>(F.lds + RING_OFF, g, S, E); }
        if (BOTH(3)) GRID_BAR();
    }
    if (IN(4)) {
        for (;;) {
            __syncthreads();
            if (F.tid == 0) F.MISC[0] = __hip_atomic_fetch_add(F.ctl + CW_QUEUE, 1u, RLX_AGENT);
            __syncthreads();
            const unsigned idx = (unsigned)__builtin_amdgcn_readfirstlane((int)F.MISC[0]);
            if (idx >= 576u) break;
            if (idx < 64u) hg::hgrn_task(F.lds + RING_OFF, GL, QH, HI, GS, hg_norm_g, OAB + (size_t)MTOK * 2048, (int)(idx >> 4), (int)(idx & 15u), F.tid);
            else { const unsigned u = idx - 64u; const int qb = 7 - (int)(u >> 6), bh = (int)(u & 63u);
                att::attn_unit(F.lds + RING_OFF, Q, KV, KROPE, OAB, bh >> 4, bh & 15, qb, F.tid); }
        }
        __syncthreads();
        if (BOTH(4)) GRID_BAR();
    }
    if (IN(5)) {
        pg8::Gemm g{OAB, Wt_ab, 2 * MTOK, 8192, 2048}; pg8::DualOrder S; S.S.init(MTOK, 4096, F.G, (int)blockIdx.x);
        pg8::EpiMerge E{GA, GB, MERGED};
        pg8::gemm_phase<pg8::EpiMerge, pg8::DualOrder, true, true>(F.lds + RING_OFF, g, S, E);
        if (BOTH(5)) GRID_BAR();
    }
    if (IN(6)) {
        pg8::Gemm g{MERGED, Wt_out, MTOK, 4096, 4096}; pg8::StaticOrder S; S.init(MTOK, 4096, F.G, (int)blockIdx.x);
        pg8::EpiMix E{x, ST, ln_in_g, ln_in_b, R, ALPHA};
        pg8::gemm_phase<pg8::EpiMix, pg8::StaticOrder, true, true>(F.lds + RING_OFF, g, S, E);
        if (BOTH(6)) GRID_BAR();
    }
    if (IN(7)) {
        for (int m = gw; m < MTOK; m += NGW) ln_row<true, true, false>(R + (size_t)m * DM, ln1_g, ln1_b, R + (size_t)m * DM, HB + (size_t)m * DM, nullptr, F.lane);
        if (BOTH(7)) GRID_BAR();
    }
    if (IN(8)) {
        pg8::Gemm g{HB, Wt_gu, MTOK, 2 * DFF, DM}; pg8::StaticOrder S; S.init(MTOK, 2 * DFF, F.G, (int)blockIdx.x);
        pg8::EpiSwiglu E{ACT};
        pg8::gemm_phase<pg8::EpiSwiglu, pg8::StaticOrder, true, true>(F.lds + RING_OFF, g, S, E);
        if (BOTH(8)) GRID_BAR();
    }
    if (IN(9)) {
        pg8::Gemm g{ACT, Wt_down, MTOK, 4096, DFF}; pg8::StaticOrder S; S.init(MTOK, 4096, F.G, (int)blockIdx.x);
        pg8::EpiDown E{R, out, ALPHA};
        pg8::gemm_phase<pg8::EpiDown, pg8::StaticOrder, true, true>(F.lds + RING_OFF, g, S, E);
        if (BOTH(9)) GRID_BAR();
    }
    if (IN(10)) {
        for (int m = gw; m < MTOK; m += NGW) ln_row<true, false, false>(out + (size_t)m * DM, ln2_g, ln2_b, out + (size_t)m * DM, nullptr, nullptr, F.lane);
    }
#undef IN
#undef BOTH
}

extern "C" void kernel_launch(void* const* d_in, const int* in_sizes, int n_in, void* d_out, int out_size, void* d_ws, size_t ws_size, hipStream_t stream) {
    static int grid = 0;
    if (grid == 0) {
        if (n_in != 21 || out_size != MTOK * DM || ws_size < WS_END) { fprintf(stderr, "kernel_launch: unexpected shapes (n_in %d, out %d, ws %zu, need %zu)\n", n_in, out_size, ws_size, (size_t)WS_END); grid = -1; return; }
        int dev = 0, cus = 0, per_cu = 0;
        if (hipGetDevice(&dev) != hipSuccess || hipDeviceGetAttribute(&cus, hipDeviceAttributeMultiprocessorCount, dev) != hipSuccess) { grid = -1; return; }
        if (hipFuncSetAttribute((const void*)mega_fwd, hipFuncAttributeMaxDynamicSharedMemorySize, LDS_BYTES) != hipSuccess) { fprintf(stderr, "kernel_launch: hipFuncSetAttribute failed\n"); grid = -1; return; }
        if (hipOccupancyMaxActiveBlocksPerMultiprocessor(&per_cu, (const void*)mega_fwd, NWAVES * 64, LDS_BYTES) != hipSuccess || per_cu < 1)
            fprintf(stderr, "kernel_launch: note: occupancy query reports %d workgroups per CU\n", per_cu);
        (void)hipGetLastError();
        grid = cus;
    }
    if (grid < 0) return;
    if (hipMemsetAsync((char*)d_ws + WS_CTL, 0, CTL_ZERO_BYTES, stream) != hipSuccess) return;
    Args a{};
    for (int i = 0; i < 21; ++i) a.in[i] = d_in[i];
    a.out = (float*)d_out; a.ws = (unsigned char*)d_ws;
#if MK_ONE_LAUNCH
    a.ph_lo = 0; a.ph_hi = NPHASE;
    hipLaunchKernelGGL(mega_fwd, dim3(grid), dim3(NWAVES * 64), LDS_BYTES, stream, a);
#else
    for (int p = 0; p < NPHASE; ++p) { a.ph_lo = p; a.ph_hi = p + 1; hipLaunchKernelGGL(mega_fwd, dim3(grid), dim3(NWAVES * 64), LDS_BYTES, stream, a); }
#endif
}
```

```cpp
#define MK_ONE_LAUNCH 1
#include <hip/hip_runtime.h>
#include <cstdio>
#include <cstdint>
namespace pg8 {
#define PG8_LAS __attribute__((address_space(3)))
typedef unsigned short bf16_t;
typedef short bf16x8 __attribute__((ext_vector_type(8)));
typedef float f32x4 __attribute__((ext_vector_type(4)));
typedef unsigned u32x4 __attribute__((ext_vector_type(4)));
constexpr int BM = 256, BK = 64, HALF = 128, HTB = HALF * BK * 2  , STAGE_BYTES = 8 * HTB, NXCD = 8, WGM = 8;

__host__ __device__ __forceinline__ int lds_byte(int r, int c) { const int st = (r >> 4) * 2 + (c >> 5), rr = r & 15, cc = c & 31, ob = rr * 64 + cc * 2; return st * 1024 + (ob ^ (((ob >> 9) & 1) << 5)); }
__host__ __device__ __forceinline__ void stage_rc(int b, int& R, int& C) { const int st = b / 1024, sb = b % 1024, swz = sb ^ (((sb >> 9) & 1) << 5); R = (st >> 1) * 16 + swz / 64; C = (st & 1) * 32 + (swz % 64) / 2; }
__host__ __device__ __forceinline__ int perm32(int rho) { const int n = rho >> 4, i = rho & 15; return 8 * (i >> 2) + 4 * n + (i & 3); }

struct Unit { int pm, pn; };
struct Gemm { const bf16_t* A; const bf16_t* Bt; int M, N, K, lda; };

struct StaticOrder {
    int nM, nN, nwg, G, c;
    __host__ __device__ void init(int M, int N, int G_, int c_) { nM = M / BM; nN = N / BM; nwg = nM * nN; G = G_; c = c_; }
    __host__ __device__ bool next(int i, Unit& u) const {
        const long L = (long)i * G + c; if (L >= nwg) return false;
        int wgid = (int)L; { const int q = nwg / NXCD, r = nwg % NXCD, xcd = wgid % NXCD, off = wgid / NXCD; wgid = (xcd < r ? xcd * (q + 1) : r * (q + 1) + (xcd - r) * q) + off; }
        const int nig = WGM * nN, gid = wgid / nig, fm = gid * WGM, gsz = (nM - fm) < WGM ? (nM - fm) : WGM;
        u.pm = fm + ((wgid % nig) % gsz); u.pn = (wgid % nig) / gsz; return true;
    }
    __device__ __forceinline__ void a_ready(const Unit&) const {}
    __device__ __forceinline__ void done(const Unit&) const {}
};

__device__ __forceinline__ unsigned cvt_pk_bf16(float lo, float hi) { unsigned r; asm volatile("v_cvt_pk_bf16_f32 %0, %1, %2" : "=v"(r) : "v"(lo), "v"(hi)); return r; }
typedef float f32x2 __attribute__((ext_vector_type(2)));
__device__ __forceinline__ f32x2 gelu_pk(f32x2 v) {
    const f32x2 av = __builtin_elementwise_abs(v), d = av * 0.2316418882f + 1.0f;
    f32x2 t; t.x = __builtin_amdgcn_rcpf(d.x); t.y = __builtin_amdgcn_rcpf(d.y);
    f32x2 q = t * 0.5307027145f + (-0.7265760135f); q = q * t + 0.7107068705f; q = q * t + (-0.142248368f); q = q * t + 0.127414796f; q = q * t;
    const f32x2 s = (v * v) * (-0.72134752044f);
    f32x2 e; e.x = __builtin_amdgcn_exp2f(s.x); e.y = __builtin_amdgcn_exp2f(s.y);
    const f32x2 m = v * (q * e), r = v - m;
    f32x2 o; o.x = v.x < 0.f ? m.x : r.x; o.y = v.y < 0.f ? m.y : r.y; return o;
}

template <class Epi, class Sched, bool ALIGN_EPI = false, bool SP2 = false>
__device__ __forceinline__ void gemm_phase(PG8_LAS unsigned char* lds, const Gemm g, const Sched& S, const Epi& E) {
    const int tid = threadIdx.x, wid = __builtin_amdgcn_readfirstlane(tid >> 6), lane = tid & 63, wr = wid >> 2, wc = wid & 3, fr = lane & 15, fq = lane >> 4;
    const int K = g.K, nt = K / BK;
    unsigned voffA[2], voffB[2];
#pragma unroll
    for (int i = 0; i < 2; ++i) { int R, C; stage_rc(tid * 16 + i * 8192, R, C); const int Rb = Epi::PERM ? ((R & ~31) + perm32(R & 31)) : R;
        voffA[i] = (unsigned)(R * g.lda + C) * 2u; voffB[i] = (unsigned)(Rb * BK + C) * 2u; }
    const size_t kstep = (size_t)(BK * 2);
    const size_t hstep = (size_t)HALF * g.lda * 2;
    const size_t tstep = 2 * hstep;
    const size_t kstepB = 32768, hstepB = 16384, tstepB = (size_t)nt * 32768;
    const unsigned ldsw = (unsigned)wid * 1024u;
    const int aoff = lds_byte(wr * 64 + fr, fq * 8), boff = lds_byte(wc * 32 + fr, fq * 8);
#define PG8_SA(b, h) (((b) * 2 + (h)) * HTB)
#define PG8_SB(b, h) ((4 + (b) * 2 + (h)) * HTB)
#define PG8_STAGE(bufoff, gbase, voff) do { _Pragma("unroll") for (int _i = 0; _i < 2; ++_i) \
        __builtin_amdgcn_global_load_lds((const unsigned*)((const char*)(gbase) + (voff)[_i]), (PG8_LAS unsigned*)(lds + (bufoff) + ldsw + _i * 8192), 16, 0, 0); } while (0)
#define PG8_LDA(dst, b, h) do { _Pragma("unroll") for (int m = 0; m < 4; ++m) _Pragma("unroll") for (int k = 0; k < 2; ++k) dst[m][k] = *(const PG8_LAS bf16x8*)(lds + PG8_SA(b, h) + aoff + m * 2048 + k * 1024); } while (0)
#define PG8_LDB(dst, b, h) do { _Pragma("unroll") for (int n = 0; n < 2; ++n) _Pragma("unroll") for (int k = 0; k < 2; ++k) dst[n][k] = *(const PG8_LAS bf16x8*)(lds + PG8_SB(b, h) + boff + n * 2048 + k * 1024); } while (0)
#define PG8_MMA(ai, bj, At, Bt) do { __builtin_amdgcn_s_setprio(1); _Pragma("unroll") for (int m = 0; m < 4; ++m) _Pragma("unroll") for (int n = 0; n < 2; ++n) _Pragma("unroll") for (int k = 0; k < 2; ++k) \
        acc[ai][bj][m][n] = __builtin_amdgcn_mfma_f32_16x16x32_bf16(Bt[n][k], At[m][k], acc[ai][bj][m][n], 0, 0, 0); __builtin_amdgcn_s_setprio(0); } while (0)
#define PG8_WAIT_V(n) asm volatile("s_waitcnt vmcnt(" #n ")" ::: "memory")
#define PG8_WAIT_L(n) asm volatile("s_waitcnt lgkmcnt(" #n ")" ::: "memory")
#define PG8_BAR __builtin_amdgcn_s_barrier()
#define PG8_SCHED __builtin_amdgcn_sched_barrier(0)
    Unit cur, nxt; int ui = 0;
    if (!S.next(0, cur)) return;
    f32x4 acc[2][2][4][2];
#pragma unroll
    for (int a = 0; a < 2; ++a)
#pragma unroll
        for (int b = 0; b < 2; ++b)
#pragma unroll
            for (int m = 0; m < 4; ++m)
#pragma unroll
                for (int n = 0; n < 2; ++n) acc[a][b][m][n] = (f32x4){0.f, 0.f, 0.f, 0.f};
    bf16x8 At[4][2], B0[2][2], B1[2][2];
    const char* cA = (const char*)g.A + (size_t)cur.pm * tstep; const char* cB = (const char*)g.Bt + (size_t)cur.pn * tstepB;
    S.a_ready(cur);
    if constexpr (SP2) {
        PG8_STAGE(PG8_SB(0, 0), cB, voffB); PG8_STAGE(PG8_SB(0, 1), cB + hstepB, voffB); PG8_STAGE(PG8_SA(0, 0), cA, voffA); PG8_STAGE(PG8_SA(0, 1), cA + hstep, voffA);
        if (wr == 1) PG8_BAR;
        PG8_WAIT_V(2); PG8_BAR;
        PG8_STAGE(PG8_SB(1, 0), cB + kstepB, voffB); PG8_STAGE(PG8_SA(1, 0), cA + kstep, voffA); PG8_STAGE(PG8_SB(1, 1), cB + hstepB + kstepB, voffB);
        PG8_WAIT_V(6); PG8_BAR;
    } else {
        PG8_STAGE(PG8_SB(0, 0), cB, voffB); PG8_STAGE(PG8_SA(0, 0), cA, voffA); PG8_STAGE(PG8_SB(0, 1), cB + hstepB, voffB); PG8_STAGE(PG8_SA(0, 1), cA + hstep, voffA);
        if (wr == 1) PG8_BAR;
        PG8_WAIT_V(4); PG8_BAR;
        PG8_STAGE(PG8_SB(1, 0), cB + kstepB, voffB); PG8_STAGE(PG8_SA(1, 0), cA + kstep, voffA); PG8_STAGE(PG8_SB(1, 1), cB + hstepB + kstepB, voffB);
        PG8_WAIT_V(6); PG8_BAR;
    }
    for (;;) {
        const bool has_next = S.next(ui + 1, nxt);
        const char* nA = has_next ? (const char*)g.A + (size_t)nxt.pm * tstep : cA; const char* nB = has_next ? (const char*)g.Bt + (size_t)nxt.pn * tstepB : cB;
        for (int t = 0; t < nt; t += 2) {
            const bool last = (t == nt - 2);
            const char* a1 = cA + (size_t)(t + 1) * kstep;
            const char* a2 = last ? nA : cA + (size_t)(t + 2) * kstep; const char* b2 = last ? nB : cB + (size_t)(t + 2) * kstepB;
            const char* a3 = a2 + kstep; const char* b3 = b2 + kstepB;
            if (last && has_next) S.a_ready(nxt);
            if constexpr (SP2) {
            PG8_LDB(B0, 0, 0); PG8_LDB(B1, 0, 1); PG8_SCHED; PG8_LDA(At, 0, 0); PG8_STAGE(PG8_SA(1, 1), a1 + hstep, voffA);
            PG8_WAIT_V(8); PG8_WAIT_L(0); PG8_BAR; PG8_MMA(0, 0, At, B0); PG8_MMA(0, 1, At, B1); PG8_BAR; PG8_SCHED;
            PG8_LDA(At, 0, 1); PG8_STAGE(PG8_SB(0, 0), b2, voffB); PG8_STAGE(PG8_SB(0, 1), b2 + hstepB, voffB); PG8_STAGE(PG8_SA(0, 0), a2, voffA);
            PG8_WAIT_V(8); PG8_WAIT_L(0); PG8_BAR; PG8_MMA(1, 0, At, B0); PG8_MMA(1, 1, At, B1); PG8_BAR; PG8_SCHED;
            PG8_LDB(B0, 1, 0); PG8_LDB(B1, 1, 1); PG8_SCHED; PG8_LDA(At, 1, 0); PG8_STAGE(PG8_SA(0, 1), a2 + hstep, voffA);
            PG8_WAIT_V(8); PG8_WAIT_L(0); PG8_BAR; PG8_MMA(0, 0, At, B0); PG8_MMA(0, 1, At, B1); PG8_BAR; PG8_SCHED;
            PG8_LDA(At, 1, 1); PG8_STAGE(PG8_SB(1, 0), b3, voffB); PG8_STAGE(PG8_SB(1, 1), b3 + hstepB, voffB); PG8_STAGE(PG8_SA(1, 0), a3, voffA);
            PG8_WAIT_V(8); PG8_WAIT_L(0); PG8_BAR; PG8_MMA(1, 0, At, B0); PG8_MMA(1, 1, At, B1); PG8_BAR; PG8_SCHED;
            } else {
            PG8_LDB(B0, 0, 0); PG8_SCHED; PG8_LDA(At, 0, 0); PG8_STAGE(PG8_SA(1, 1), a1 + hstep, voffA);
            PG8_WAIT_L(8); PG8_BAR; PG8_WAIT_L(0); PG8_MMA(0, 0, At, B0); PG8_BAR; PG8_SCHED;
            PG8_LDB(B1, 0, 1); PG8_STAGE(PG8_SB(0, 0), b2, voffB);
            PG8_BAR; PG8_WAIT_L(0); PG8_MMA(0, 1, At, B1); PG8_BAR;
            PG8_LDA(At, 0, 1); PG8_STAGE(PG8_SA(0, 0), a2, voffA);
            PG8_BAR; PG8_WAIT_L(0); PG8_MMA(1, 0, At, B0); PG8_BAR; PG8_SCHED;
            PG8_STAGE(PG8_SB(0, 1), b2 + hstepB, voffB);
            PG8_WAIT_V(6); PG8_BAR; PG8_MMA(1, 1, At, B1); PG8_BAR;
            PG8_LDB(B0, 1, 0); PG8_SCHED; PG8_LDA(At, 1, 0); PG8_STAGE(PG8_SA(0, 1), a2 + hstep, voffA);
            PG8_WAIT_L(8); PG8_BAR; PG8_WAIT_L(0); PG8_MMA(0, 0, At, B0); PG8_BAR; PG8_SCHED;
            PG8_LDB(B1, 1, 1); PG8_STAGE(PG8_SB(1, 0), b3, voffB);
            PG8_BAR; PG8_WAIT_L(0); PG8_MMA(0, 1, At, B1); PG8_BAR;
            PG8_LDA(At, 1, 1); PG8_STAGE(PG8_SA(1, 0), a3, voffA);
            PG8_BAR; PG8_WAIT_L(0); PG8_MMA(1, 0, At, B0); PG8_BAR; PG8_SCHED;
            PG8_STAGE(PG8_SB(1, 1), b3 + hstepB, voffB);
            PG8_WAIT_V(6); PG8_BAR; PG8_MMA(1, 1, At, B1); PG8_BAR;
            }
        }
        if constexpr (ALIGN_EPI) { if (wr == 0) PG8_BAR; }
        if constexpr (!Epi::AFTER_DRAIN) { E(acc, cur, wr, wc, fr, fq); S.done(cur); }
        if (!has_next) break;
        if (!E.keep(cur)) {
#pragma unroll
        for (int a = 0; a < 2; ++a)
#pragma unroll
            for (int b = 0; b < 2; ++b)
#pragma unroll
                for (int m = 0; m < 4; ++m)
#pragma unroll
                    for (int n = 0; n < 2; ++n) acc[a][b][m][n] = (f32x4){0.f, 0.f, 0.f, 0.f};
        }
        cur = nxt; cA = nA; cB = nB; ++ui;
        if constexpr (ALIGN_EPI) { if (wr == 1) PG8_BAR; }
    }
    PG8_WAIT_V(0);
    if constexpr (!ALIGN_EPI) { if (wr == 0) PG8_BAR; }
    PG8_BAR;
    if constexpr (Epi::AFTER_DRAIN) { E.fused(acc, cur, wr, wc, fr, fq, lds, wid, lane); S.done(cur); }
#undef PG8_SA
#undef PG8_SB
#undef PG8_STAGE
#undef PG8_LDA
#undef PG8_LDB
#undef PG8_MMA
#undef PG8_WAIT_V
#undef PG8_WAIT_L
#undef PG8_BAR
#undef PG8_SCHED
}
}

namespace pg8 {
__device__ __forceinline__ float bf2f(unsigned short h) { return __uint_as_float(((unsigned)h) << 16); }
__device__ __forceinline__ float bflo(unsigned w) { return __uint_as_float(w << 16); }
__device__ __forceinline__ float bfhi(unsigned w) { return __uint_as_float(w & 0xffff0000u); }
__device__ __forceinline__ float sigm(float x) { return __builtin_amdgcn_rcpf(1.f + __builtin_amdgcn_exp2f(-1.4426950408889634f * x)); }
__device__ __forceinline__ u32x4 pack8(f32x4 a, f32x4 b) { u32x4 w; w.x = cvt_pk_bf16(a[0], a[1]); w.y = cvt_pk_bf16(a[2], a[3]); w.z = cvt_pk_bf16(b[0], b[1]); w.w = cvt_pk_bf16(b[2], b[3]); return w; }

struct EpiProj {
    static constexpr bool PERM = true, AFTER_DRAIN = false;
    float* CF; bf16_t* QH; float* G; bf16_t* HI; bf16_t* GS; bf16_t* GA; bf16_t* GB; const float* hg_lb;
    __device__ __forceinline__ bool keep(const Unit&) const { return false; }
    __device__ __forceinline__ void operator()(f32x4 (&acc)[2][2][4][2], const Unit& u, int wr, int wc, int fr, int fq) const {
        const int pn = u.pn; int mode, ct, ldc; float* pf = nullptr; bf16_t* ph = nullptr;
        if (pn < 7) { mode = 0; ct = pn; ldc = 1792; pf = CF; }
        else if (pn < 15) { mode = 1; ct = pn - 7; ldc = 2048; ph = QH; }
        else if (pn < 23) { mode = 2; ct = pn - 15; ldc = 2048; pf = G; }
        else if (pn < 31) { mode = 3; ct = pn - 23; ldc = 2048; ph = HI; }
        else if (pn < 39) { mode = 1; ct = pn - 31; ldc = 2048; ph = GS; }
        else if (pn < 55) { mode = 4; ct = pn - 39; ldc = 4096; ph = GA; }
        else { mode = 4; ct = pn - 55; ldc = 4096; ph = GB; }
        const int row0 = u.pm * BM + wr * 64 + fr, col0 = ct * BM + wc * 32 + 8 * fq;
        if (mode == 0) {
#pragma unroll
            for (int ai = 0; ai < 2; ++ai)
#pragma unroll
                for (int m = 0; m < 4; ++m) { float* rowp = pf + (size_t)(row0 + ai * HALF + m * 16) * ldc + col0;
#pragma unroll
                    for (int bj = 0; bj < 2; ++bj) { *(f32x4*)(rowp + bj * HALF) = acc[ai][bj][m][0]; *(f32x4*)(rowp + bj * HALF + 4) = acc[ai][bj][m][1]; } }
        } else if (mode == 2) {
#pragma unroll
            for (int bj = 0; bj < 2; ++bj) {
                f32x4 lb[2];
#pragma unroll
                for (int n = 0; n < 2; ++n) { const f32x4 l0 = *(const f32x4*)(hg_lb + col0 + bj * HALF + 4 * n), l1 = *(const f32x4*)(hg_lb + 2048 + col0 + bj * HALF + 4 * n);
#pragma unroll
                    for (int i = 0; i < 4; ++i) lb[n][i] = sigm(l0[i] - l1[i]); }
#pragma unroll
                for (int ai = 0; ai < 2; ++ai)
#pragma unroll
                    for (int m = 0; m < 4; ++m) { float* rowp = pf + (size_t)(row0 + ai * HALF + m * 16) * ldc + col0 + bj * HALF;
#pragma unroll
                        for (int n = 0; n < 2; ++n) { f32x4 v = acc[ai][bj][m][n], o;
#pragma unroll
                            for (int i = 0; i < 4; ++i) { const float f = lb[n][i] + (1.f - lb[n][i]) * sigm(v[i]); o[i] = __builtin_amdgcn_logf(f) * 0.6931471805599453f; }
                            *(f32x4*)(rowp + 4 * n) = o; } }
            }
        } else {
#pragma unroll
            for (int ai = 0; ai < 2; ++ai)
#pragma unroll
                for (int m = 0; m < 4; ++m) { bf16_t* rowp = ph + (size_t)(row0 + ai * HALF + m * 16) * ldc + col0;
#pragma unroll
                    for (int bj = 0; bj < 2; ++bj) { f32x4 v0 = acc[ai][bj][m][0], v1 = acc[ai][bj][m][1];
                        if (mode == 1) {
#pragma unroll
                            for (int i = 0; i < 4; ++i) { v0[i] = v0[i] * sigm(v0[i]); v1[i] = v1[i] * sigm(v1[i]); } }
                        else if (mode == 4) {
#pragma unroll
                            for (int i = 0; i < 4; ++i) { v0[i] = sigm(v0[i]); v1[i] = sigm(v1[i]); } }
                        *(u32x4*)(rowp + bj * HALF) = pack8(v0, v1); } }
        }
    }
};
struct EpiPlain {
    static constexpr bool PERM = true, AFTER_DRAIN = false;
    bf16_t* O; int ldc;
    __device__ __forceinline__ bool keep(const Unit&) const { return false; }
    __device__ __forceinline__ void operator()(f32x4 (&acc)[2][2][4][2], const Unit& u, int wr, int wc, int fr, int fq) const {
        const int row0 = u.pm * BM + wr * 64 + fr, col0 = u.pn * BM + wc * 32 + 8 * fq;
#pragma unroll
        for (int ai = 0; ai < 2; ++ai)
#pragma unroll
            for (int m = 0; m < 4; ++m) { bf16_t* rowp = O + (size_t)(row0 + ai * HALF + m * 16) * ldc + col0;
#pragma unroll
                for (int bj = 0; bj < 2; ++bj) *(u32x4*)(rowp + bj * HALF) = pack8(acc[ai][bj][m][0], acc[ai][bj][m][1]); }
    }
};
struct EpiQ {
    static constexpr bool PERM = true, AFTER_DRAIN = false;
    bf16_t* Q; const float* CS;
    __device__ __forceinline__ bool keep(const Unit&) const { return false; }
    __device__ __forceinline__ void operator()(f32x4 (&acc)[2][2][4][2], const Unit& u, int wr, int wc, int fr, int fq) const {
        const int row0 = u.pm * BM + wr * 64 + fr;
#pragma unroll
        for (int bj = 0; bj < 2; ++bj) {
            const int gi = u.pn * 8 + bj * 4 + wc, part = gi % 6, col0 = gi * 32 + 8 * fq;
            if (part < 4) {
#pragma unroll
                for (int ai = 0; ai < 2; ++ai)
#pragma unroll
                    for (int m = 0; m < 4; ++m) *(u32x4*)(Q + (size_t)(row0 + ai * HALF + m * 16) * 3072 + col0) = pack8(acc[ai][bj][m][0], acc[ai][bj][m][1]);
            } else {
                const int i0 = (part - 4) * 16 + 4 * fq;
#pragma unroll
                for (int ai = 0; ai < 2; ++ai)
#pragma unroll
                    for (int m = 0; m < 4; ++m) { const int row = row0 + ai * HALF + m * 16;
                        const f32x4 c = *(const f32x4*)(CS + (size_t)row * 64 + i0), s = *(const f32x4*)(CS + (size_t)row * 64 + 32 + i0);
                        const f32x4 v0 = acc[ai][bj][m][0], v1 = acc[ai][bj][m][1]; f32x4 o0, o1;
                        o0[0] = v0[0] * c[0] - v0[1] * s[0]; o0[1] = v0[0] * s[0] + v0[1] * c[0]; o0[2] = v0[2] * c[1] - v0[3] * s[1]; o0[3] = v0[2] * s[1] + v0[3] * c[1];
                        o1[0] = v1[0] * c[2] - v1[1] * s[2]; o1[1] = v1[0] * s[2] + v1[1] * c[2]; o1[2] = v1[2] * c[3] - v1[3] * s[3]; o1[3] = v1[2] * s[3] + v1[3] * c[3];
                        *(u32x4*)(Q + (size_t)row * 3072 + col0) = pack8(o0, o1); }
            }
        }
    }
};
struct EpiMerge {
    static constexpr bool PERM = true, AFTER_DRAIN = false;
    const bf16_t* GA; const bf16_t* GB; bf16_t* O;
    __device__ __forceinline__ bool keep(const Unit& u) const { return u.pm < 32; }
    __device__ __forceinline__ void operator()(f32x4 (&acc)[2][2][4][2], const Unit& u, int wr, int wc, int fr, int fq) const {
        const bool second = u.pm >= 32;
        const int row0 = (u.pm & 31) * BM + wr * 64 + fr, col0 = (u.pn & 15) * BM + wc * 32 + 8 * fq;
#pragma unroll
        for (int ai = 0; ai < 2; ++ai)
#pragma unroll
            for (int m = 0; m < 4; ++m) { const size_t off = (size_t)(row0 + ai * HALF + m * 16) * 4096 + col0;
#pragma unroll
                for (int bj = 0; bj < 2; ++bj) {
                    const u32x4 gb = *(const u32x4*)(GB + off + bj * HALF);
                    f32x4 b0, b1; b0[0] = bflo(gb.x); b0[1] = bfhi(gb.x); b0[2] = bflo(gb.y); b0[3] = bfhi(gb.y); b1[0] = bflo(gb.z); b1[1] = bfhi(gb.z); b1[2] = bflo(gb.w); b1[3] = bfhi(gb.w);
#pragma unroll
                    for (int i = 0; i < 4; ++i) { b0[i] = fmaxf(b0[i], 1e-30f); b1[i] = fmaxf(b1[i], 1e-30f); }
                    if (!second) {
                        const u32x4 ga = *(const u32x4*)(GA + off + bj * HALF);
                        f32x4 a0, a1; a0[0] = bflo(ga.x); a0[1] = bfhi(ga.x); a0[2] = bflo(ga.y); a0[3] = bfhi(ga.y); a1[0] = bflo(ga.z); a1[1] = bfhi(ga.z); a1[2] = bflo(ga.w); a1[3] = bfhi(ga.w);
#pragma unroll
                        for (int i = 0; i < 4; ++i) { acc[ai][bj][m][0][i] *= a0[i] * __builtin_amdgcn_rcpf(b0[i]); acc[ai][bj][m][1][i] *= a1[i] * __builtin_amdgcn_rcpf(b1[i]); }
                    } else {
                        *(u32x4*)(O + off + bj * HALF) = pack8(acc[ai][bj][m][0] * b0, acc[ai][bj][m][1] * b1);
                    }
                } }
    }
};
struct DualOrder {
    StaticOrder S;
    __device__ __forceinline__ bool next(int i, Unit& u) const { if (!S.next(i >> 1, u)) return false; if (i & 1) { u.pm += 32; u.pn += 16; } return true; }
    __device__ __forceinline__ void a_ready(const Unit&) const {}
    __device__ __forceinline__ void done(const Unit&) const {}
};
struct EpiMix {
    static constexpr bool PERM = false, AFTER_DRAIN = false;
    const float* X; const float* ST; const float* g; const float* b; float* Y; float alpha;
    __device__ __forceinline__ bool keep(const Unit&) const { return false; }
    __device__ __forceinline__ void operator()(f32x4 (&acc)[2][2][4][2], const Unit& u, int wr, int wc, int fr, int fq) const {
        const int row0 = u.pm * BM + wr * 64 + fr, col0 = u.pn * BM + wc * 32 + 4 * fq;
#pragma unroll
        for (int ai = 0; ai < 2; ++ai)
#pragma unroll
            for (int m = 0; m < 4; ++m) { const int row = row0 + ai * HALF + m * 16; const float mu = ST[2 * row], rs = ST[2 * row + 1]; const size_t off = (size_t)row * 4096 + col0;
#pragma unroll
                for (int bj = 0; bj < 2; ++bj)
#pragma unroll
                    for (int n = 0; n < 2; ++n) { const int cc = bj * HALF + n * 16; const f32x4 xv = *(const f32x4*)(X + off + cc), gv = *(const f32x4*)(g + col0 + cc), bv = *(const f32x4*)(b + col0 + cc);
                        *(f32x4*)(Y + off + cc) = ((xv - mu) * rs * gv + bv) * alpha + acc[ai][bj][m][n]; } }
    }
};
struct EpiSwiglu {
    static constexpr bool PERM = true, AFTER_DRAIN = false;
    bf16_t* O;
    __device__ __forceinline__ bool keep(const Unit&) const { return false; }
    __device__ __forceinline__ void operator()(f32x4 (&acc)[2][2][4][2], const Unit& u, int wr, int wc, int fr, int fq) const {
        const int row0 = u.pm * BM + wr * 64 + fr, col0 = u.pn * HALF + wc * 32 + 8 * fq;
#pragma unroll
        for (int ai = 0; ai < 2; ++ai)
#pragma unroll
            for (int m = 0; m < 4; ++m) { f32x4 o0, o1;
#pragma unroll
                for (int i = 0; i < 4; ++i) { const float g0 = acc[ai][0][m][0][i], g1 = acc[ai][0][m][1][i]; o0[i] = g0 * sigm(g0) * acc[ai][1][m][0][i]; o1[i] = g1 * sigm(g1) * acc[ai][1][m][1][i]; }
                *(u32x4*)(O + (size_t)(row0 + ai * HALF + m * 16) * 11008 + col0) = pack8(o0, o1); }
    }
};
struct EpiDown {
    static constexpr bool PERM = false, AFTER_DRAIN = false;
    const float* H1; float* Z; float alpha;
    __device__ __forceinline__ bool keep(const Unit&) const { return false; }
    __device__ __forceinline__ void operator()(f32x4 (&acc)[2][2][4][2], const Unit& u, int wr, int wc, int fr, int fq) const {
        const int row0 = u.pm * BM + wr * 64 + fr, col0 = u.pn * BM + wc * 32 + 4 * fq;
#pragma unroll
        for (int ai = 0; ai < 2; ++ai)
#pragma unroll
            for (int m = 0; m < 4; ++m) { const size_t off = (size_t)(row0 + ai * HALF + m * 16) * 4096 + col0;
#pragma unroll
                for (int bj = 0; bj < 2; ++bj)
#pragma unroll
                    for (int n = 0; n < 2; ++n) { const int cc = bj * HALF + n * 16; *(f32x4*)(Z + off + cc) = *(const f32x4*)(H1 + off + cc) * alpha + acc[ai][bj][m][n]; } }
    }
};
}

#ifndef MK_ONE_LAUNCH
#define MK_ONE_LAUNCH 0
#endif
#ifndef PROBE_REP
#define PROBE_REP (-1)
#endif
constexpr int NWAVES = 8;
constexpr int NPHASE = 11;
constexpr int MTOK = 8192, DM = 4096, DFF = 11008, NPROJ = 18176;
constexpr int LDH = DM + 64;
constexpr float LN_EPS = 1e-5f;
constexpr float ALPHA = 1.189207115002721f;
constexpr float QSCALE = 0.07216878364870322f * 1.4426950408889634f;
constexpr size_t MiB = 1u << 20;
constexpr size_t WS_CTL = 0, CTL_ZERO_BYTES = 1 * MiB;
constexpr size_t WS_CS = 1 * MiB;
constexpr size_t WS_ST = 3 * MiB;
constexpr size_t WS_WIN = 8 * MiB;
constexpr size_t WS_Q = 8 * MiB;
constexpr size_t WS_KV = 56 * MiB;
constexpr size_t WS_CQN = 120 * MiB;
constexpr size_t WS_CKVN = 136 * MiB;
constexpr size_t WS_KROPE = 144 * MiB;
constexpr size_t WS_WUQ = 150 * MiB, WS_WUKV = 156 * MiB, WS_WAB = 160 * MiB, WS_WOUT = 192 * MiB, WS_WGU = 224 * MiB, WS_WDOWN = 396 * MiB;
constexpr size_t WS_HB = 482 * MiB;
constexpr size_t WS_CF = 548 * MiB;
constexpr size_t WS_QH = 604 * MiB, WS_G = 636 * MiB, WS_HI = 700 * MiB, WS_GS = 732 * MiB, WS_GA = 764 * MiB, WS_GB = 828 * MiB;
constexpr size_t WS_R = 548 * MiB;
constexpr size_t WS_ACT = 676 * MiB;
constexpr size_t WS_OAB = 892 * MiB;
constexpr size_t WS_END = 956 * MiB;
static_assert(WS_WIN + (size_t)NPROJ * DM * 2 <= WS_WUQ && WS_KROPE + (size_t)MTOK * 64 * 2 <= WS_WUQ, "ws map 1");
static_assert(WS_WGU + (size_t)2 * DFF * DM * 2 <= WS_WDOWN && WS_WDOWN + (size_t)DFF * DM * 2 <= WS_HB, "ws map 2");
static_assert(WS_HB + (size_t)MTOK * LDH * 2 <= WS_CF, "ws map hb");
static_assert(WS_CF + (size_t)MTOK * 1792 * 4 <= WS_QH && WS_R + (size_t)MTOK * DM * 4 <= WS_ACT && WS_ACT + (size_t)MTOK * DFF * 2 <= WS_OAB, "ws map 3");
constexpr int CW_BAR = 4096, CW_QUEUE = 2048, CW_QUEUE2 = 3072;
constexpr int RING_OFF = 0, RING_BYTES = 131072;
constexpr int LDSCTL_OFF = RING_BYTES, MISC_OFF = LDSCTL_OFF + 320;
constexpr int LDS_BYTES = 147456;
#define GAS __attribute__((address_space(1)))
#define LAS __attribute__((address_space(3)))
typedef unsigned short bf16;
typedef unsigned v4u __attribute__((ext_vector_type(4)));
typedef float f32x4 __attribute__((ext_vector_type(4)));
typedef short bf16x8 __attribute__((ext_vector_type(8)));
typedef GAS unsigned gu32;
typedef GAS unsigned long long gu64;
#define RLX_AGENT __ATOMIC_RELAXED, __HIP_MEMORY_SCOPE_AGENT
#define LDS_WAIT() asm volatile("s_waitcnt lgkmcnt(0)" ::: "memory")
#define VM_WAIT() asm volatile("s_waitcnt vmcnt(0)" ::: "memory")
__device__ __forceinline__ unsigned long long rt() { return __builtin_amdgcn_s_memrealtime(); }
__device__ __forceinline__ unsigned f2bf(float f) { unsigned u = __builtin_bit_cast(unsigned, f); return (u + 0x7fffu + ((u >> 16) & 1u)) >> 16; }
__device__ __forceinline__ unsigned pk2(float lo, float hi) { return f2bf(lo) | (f2bf(hi) << 16); }

#define XB_TMO      128
#define XB_XCNT(j)  (256  + 64 * (j))
#define XB_XSUB(j)  (1280 + 64 * (j))
#define XB_XGEN(j)  (2304 + 64 * (j))
#define XB_TOP      3328
#define XB_TOPGEN   3392
#define XCD_BAR_WORDS 3456
#define XB_SPIN_CAP (1u << 18)

__device__ __forceinline__ unsigned xb_ld(unsigned* p)              { return __hip_atomic_load(p, __ATOMIC_RELAXED, __HIP_MEMORY_SCOPE_AGENT); }
__device__ __forceinline__ unsigned xb_add(unsigned* p, unsigned v) { return __hip_atomic_fetch_add(p, v, __ATOMIC_RELAXED, __HIP_MEMORY_SCOPE_AGENT); }
__device__ __forceinline__ unsigned xb_xcc_id() { return (unsigned)__builtin_amdgcn_s_getreg((3 << 11) | 20) & 0xFu; }
#define XB_SPIN(cond, bar) do { unsigned _sp = 0; while (cond) { __builtin_amdgcn_s_sleep(1); \
    if ((++_sp & 255u) == 0u) { if (xb_ld(&(bar)[XB_TMO])) break; if (_sp > XB_SPIN_CAP) { atomicAdd(&(bar)[XB_TMO], 1u); break; } } } } while (0)

struct XcdBarrier {
    unsigned* bar; unsigned x;
    volatile LAS unsigned* st;
};

__device__ __forceinline__ XcdBarrier xcd_barrier_post(unsigned* bar, volatile LAS unsigned* st) {
    XcdBarrier b; b.bar = bar; b.x = xb_xcc_id(); b.st = st;
    if (threadIdx.x == 0) (void)xb_add(&bar[XB_XCNT(b.x)], 1u);
    return b;
}
__device__ __forceinline__ void xcd_barrier_complete(unsigned* bar, unsigned x, unsigned& nloc, unsigned& nx) {
    const unsigned G = gridDim.x * gridDim.y * gridDim.z;
    unsigned sum, cnt, mine, sp = 0u;
    for (;;) {
        sum = 0u; cnt = 0u; mine = 0u;
#pragma unroll
        for (unsigned j = 0; j < 16; ++j) { const unsigned c = xb_ld(&bar[XB_XCNT(j)]); sum += c; cnt += (c > 0u) ? 1u : 0u; mine = (j == x) ? c : mine; }
        if (sum == G) break;
        __builtin_amdgcn_s_sleep(1);
        if ((++sp & 255u) == 0u) { if (xb_ld(&bar[XB_TMO])) break; if (sp > XB_SPIN_CAP) { atomicAdd(&bar[XB_TMO], 1u); break; } }
    }
    nloc = mine > 0u ? mine : 1u; nx = cnt > 0u ? cnt : 1u;
}

__device__ __forceinline__ void xcd_barrier(const XcdBarrier& b) {
    asm volatile("s_waitcnt vmcnt(0)" ::: "memory");
    __syncthreads();
    if (threadIdx.x == 0) {
        unsigned* bar = b.bar;
        __builtin_amdgcn_s_waitcnt(0);
        unsigned nloc = b.st[0], nx = b.st[1];
        if (nloc == 0u) { xcd_barrier_complete(bar, b.x, nloc, nx); b.st[0] = nloc; b.st[1] = nx; }
        const unsigned old = xb_add(&bar[XB_XSUB(b.x)], 1u);
        const unsigned gen = old / nloc;
        if (old + 1u == (gen + 1u) * nloc) {
            __builtin_amdgcn_fence(__ATOMIC_RELEASE, "agent");
            asm volatile("s_waitcnt vmcnt(0)" ::: "memory");
            const unsigned og = xb_add(&bar[XB_TOP], 1u);
            const unsigned tg = og / nx;
            if (og + 1u == (tg + 1u) * nx) xb_add(&bar[XB_TOPGEN], 1u);
            else XB_SPIN(xb_ld(&bar[XB_TOPGEN]) == tg, bar);
            __builtin_amdgcn_fence(__ATOMIC_ACQUIRE, "agent");
            xb_add(&bar[XB_XGEN(b.x)], 1u);
            asm volatile("s_waitcnt vmcnt(0)" ::: "memory");
        } else {
            XB_SPIN(xb_ld(&bar[XB_XGEN(b.x)]) == gen, bar);
            __builtin_amdgcn_fence(__ATOMIC_ACQUIRE, "agent");
            asm volatile("s_waitcnt vmcnt(0)" ::: "memory");
        }
    }
    __syncthreads();
}

namespace att {
typedef float f32x16 __attribute__((ext_vector_type(16)));
typedef short s16x4 __attribute__((ext_vector_type(4)));
typedef short bf16x8 __attribute__((ext_vector_type(8)));
typedef unsigned u32x4 __attribute__((ext_vector_type(4)));
typedef float f32x2_t __attribute__((ext_vector_type(2))); typedef __bf16 bf16x2_t __attribute__((ext_vector_type(2)));
constexpr int KP = 400, VP = 320, KBUF = 64 * KP, VBUF = 64 * VP, LDS_NEED = 2 * KBUF + 2 * VBUF;
__device__ __forceinline__ unsigned cvtpk(float lo, float hi) { f32x2_t v = {lo, hi}; bf16x2_t b = __builtin_convertvector(v, bf16x2_t); return __builtin_bit_cast(unsigned, b); }
__device__ __forceinline__ s16x4 vtr(const LAS unsigned char* p) { return __builtin_bit_cast(s16x4, __builtin_amdgcn_ds_read_tr16_b64_v4i16((LAS s16x4*)p)); }
__device__ __forceinline__ void attn_unit(LAS unsigned char* lds, const bf16* Q, const bf16* KV, const bf16* KROPE, bf16* OA, int b, int h, int qb, int tid) {
    const int lane = tid & 63, wid = __builtin_amdgcn_readfirstlane(tid >> 6), r32 = lane & 31, hh = lane >> 5;
    const size_t rowbase = (size_t)b * 2048;
    const int q0 = qb * 256 + wid * 32;
    bf16x8 qf[12];
    { const bf16* qrow = Q + (rowbase + q0 + r32) * 3072 + h * 192 + hh * 8;
#pragma unroll
      for (int d0 = 0; d0 < 12; ++d0) qf[d0] = *(const GAS bf16x8*)(qrow + d0 * 16); }
    const int NT = 4 * (qb + 1), myNT = 4 * qb + (wid >> 1) + 1;
    const GAS unsigned char* kvb = (const GAS unsigned char*)KV; const long krope_delta = (const unsigned char*)KROPE - (const unsigned char*)KV;
    unsigned ksrc[3], kstr[3]; int kdst[3];
#pragma unroll
    for (int i = 0; i < 3; ++i) { const int c = tid + 512 * i, row = c / 24, cc = c - row * 24;
        if (cc < 16) { ksrc[i] = (unsigned)(((rowbase + row) * 4096 + h * 256 + cc * 8) * 2); kstr[i] = 64u * 4096u * 2u; }
        else { ksrc[i] = (unsigned)(krope_delta + (long)((rowbase + row) * 64 + (cc - 16) * 8) * 2); kstr[i] = 64u * 64u * 2u; }
        kdst[i] = row * KP + cc * 16; }
    unsigned vsrc[2]; int vdst[2];
#pragma unroll
    for (int i = 0; i < 2; ++i) { const int c = tid + 512 * i, row = c >> 4, cc = c & 15; vsrc[i] = (unsigned)(((rowbase + row) * 4096 + h * 256 + 128 + cc * 8) * 2); vdst[i] = row * VP + cc * 16; }
    u32x4 kreg[3], vreg[2];
#define ATT_LOAD(t) do { _Pragma("unroll") for (int i = 0; i < 3; ++i) kreg[i] = *(const GAS u32x4*)(kvb + (ksrc[i] + (unsigned)(t) * kstr[i])); \
                         _Pragma("unroll") for (int i = 0; i < 2; ++i) vreg[i] = *(const GAS u32x4*)(kvb + (vsrc[i] + (unsigned)(t) * (64u * 4096u * 2u))); } while (0)
#define ATT_STORE(buf) do { _Pragma("unroll") for (int i = 0; i < 3; ++i) *(LAS u32x4*)(lds + (buf) * KBUF + kdst[i]) = kreg[i]; \
                            _Pragma("unroll") for (int i = 0; i < 2; ++i) *(LAS u32x4*)(lds + 2 * KBUF + (buf) * VBUF + vdst[i]) = vreg[i]; } while (0)
    __syncthreads();
    ATT_LOAD(0); ATT_STORE(0);
    __syncthreads();
    f32x16 o[4];
#pragma unroll
    for (int d = 0; d < 4; ++d)
#pragma unroll
        for (int r = 0; r < 16; ++r) o[d][r] = 0.f;
    float mrun = -1e30f, lrun = 0.f;
    const int koff = r32 * KP + hh * 16;
    const int voff = (4 * hh + ((lane & 15) >> 2)) * VP + ((lane >> 4) & 1) * 32 + (lane & 3) * 8;
    for (int t = 0; t < NT; ++t) {
        const int buf = t & 1;
        if (t + 1 < NT) ATT_LOAD(t + 1);
        if (t < myNT) {
            const LAS unsigned char* Kb = lds + buf * KBUF + koff; const LAS unsigned char* Vb = lds + 2 * KBUF + buf * VBUF + voff;
            f32x16 p0, p1;
#pragma unroll
            for (int r = 0; r < 16; ++r) { p0[r] = 0.f; p1[r] = 0.f; }
#pragma unroll
            for (int d0 = 0; d0 < 12; ++d0) {
                const bf16x8 a0 = *(const LAS bf16x8*)(Kb + d0 * 32), a1 = *(const LAS bf16x8*)(Kb + 32 * KP + d0 * 32);
                p0 = __builtin_amdgcn_mfma_f32_32x32x16_bf16(a0, qf[d0], p0, 0, 0, 0);
                p1 = __builtin_amdgcn_mfma_f32_32x32x16_bf16(a1, qf[d0], p1, 0, 0, 0);
                if ((d0 & 3) == 3) __builtin_amdgcn_sched_barrier(0);
            }
            float mt = fmaxf(p0[0], p1[0]);
#pragma unroll
            for (int r = 1; r < 16; ++r) mt = fmaxf(mt, fmaxf(p0[r], p1[r]));
            mt = fmaxf(mt, __shfl_xor(mt, 32));
            const float mn = fmaxf(mrun, mt), corr = __builtin_amdgcn_exp2f(mrun - mn); mrun = mn;
            float rs = 0.f;
#pragma unroll
            for (int r = 0; r < 16; ++r) { p0[r] = __builtin_amdgcn_exp2f(p0[r] - mn); p1[r] = __builtin_amdgcn_exp2f(p1[r] - mn); rs += p0[r] + p1[r]; }
            lrun = lrun * corr + rs;
#pragma unroll
            for (int d = 0; d < 4; ++d)
#pragma unroll
                for (int r = 0; r < 16; ++r) o[d][r] *= corr;
#pragma unroll
            for (int ks = 0; ks < 4; ++ks) {
                u32x4 pw;
                if (ks == 0) { pw.x = cvtpk(p0[0], p0[1]); pw.y = cvtpk(p0[2], p0[3]); pw.z = cvtpk(p0[4], p0[5]); pw.w = cvtpk(p0[6], p0[7]); }
                else if (ks == 1) { pw.x = cvtpk(p0[8], p0[9]); pw.y = cvtpk(p0[10], p0[11]); pw.z = cvtpk(p0[12], p0[13]); pw.w = cvtpk(p0[14], p0[15]); }
                else if (ks == 2) { pw.x = cvtpk(p1[0], p1[1]); pw.y = cvtpk(p1[2], p1[3]); pw.z = cvtpk(p1[4], p1[5]); pw.w = cvtpk(p1[6], p1[7]); }
                else { pw.x = cvtpk(p1[8], p1[9]); pw.y = cvtpk(p1[10], p1[11]); pw.z = cvtpk(p1[12], p1[13]); pw.w = cvtpk(p1[14], p1[15]); }
                const bf16x8 pf = __builtin_bit_cast(bf16x8, pw);
#pragma unroll
                for (int d = 0; d < 4; ++d) {
                    const s16x4 lo = vtr(Vb + (16 * ks) * VP + d * 64), hi = vtr(Vb + (16 * ks + 8) * VP + d * 64);
                    const bf16x8 vf = {lo[0], lo[1], lo[2], lo[3], hi[0], hi[1], hi[2], hi[3]};
                    o[d] = __builtin_amdgcn_mfma_f32_32x32x16_bf16(vf, pf, o[d], 0, 0, 0);
                }
                __builtin_amdgcn_sched_barrier(0);
            }
        }
        if (t + 1 < NT) ATT_STORE(buf ^ 1);
        __syncthreads();
    }
    lrun += __shfl_xor(lrun, 32);
    const float il = 1.f / lrun;
    bf16* orow = OA + (rowbase + q0 + r32) * 2048 + h * 128 + 4 * hh;
#pragma unroll
    for (int d = 0; d < 4; ++d)
#pragma unroll
        for (int g = 0; g < 4; ++g) {
            const unsigned w0 = cvtpk(o[d][4 * g] * il, o[d][4 * g + 1] * il), w1 = cvtpk(o[d][4 * g + 2] * il, o[d][4 * g + 3] * il);
            *(GAS unsigned long long*)(orow + d * 32 + 8 * g) = (unsigned long long)w0 | ((unsigned long long)w1 << 32);
        }
#undef ATT_LOAD
#undef ATT_STORE
}
}

namespace hg {
typedef float f32x4 __attribute__((ext_vector_type(4)));
typedef short bf16x8 __attribute__((ext_vector_type(8)));
typedef unsigned u32x4 __attribute__((ext_vector_type(4)));
constexpr int PQ = 272, PS = 144;
constexpr int CH_QT = 16384, CH_KH = 16384, CH_VT = 16384, CH_AS = 8192;
__device__ __forceinline__ unsigned cvtpk(float lo, float hi) { return att::cvtpk(lo, hi); }
__device__ __forceinline__ unsigned short cvt1(float v) { return (unsigned short)(att::cvtpk(v, 0.f) & 0xffffu); }
#define HG_MFMA(a, b, c) __builtin_amdgcn_mfma_f32_16x16x32_bf16((a), (b), (c), 0, 0, 0)

constexpr int P_G = 0, P_QS = 33792, P_VS = 51200, P_QT = 68608, P_KT = 86016, P_TOT = 103424, P_NEED = P_TOT + 2048;
__device__ __forceinline__ void hgrn_prep(LAS unsigned char* lds, const float* GL, const bf16* QH, const bf16* HI, unsigned char* SQK, unsigned char* SVA, float* SD, int bh, int c0, int tid) {
    const int lane = tid & 63, w = __builtin_amdgcn_readfirstlane(tid >> 6), l15 = lane & 15, q4 = lane >> 4;
    const int seg = tid >> 7, kk = tid & 127, tt = w >> 1, vh = w & 1;
    const int b = bh >> 4, h = bh & 15;
    LAS float* TOT = (LAS float*)(lds + P_TOT);
    const int r = tid >> 5, c4 = (tid & 31) * 4, r2 = tid >> 4, c8 = (tid & 15) * 8;
    f32x4 gl[4]; u32x4 ql[2], vl[2];
#define HGP_LOAD(c) do { const size_t base_ = ((size_t)b * 2048 + (c) * 64) * 2048 + h * 128; \
        _Pragma("unroll") for (int i = 0; i < 4; ++i) gl[i] = *(const GAS f32x4*)(GL + base_ + (size_t)(r + 16 * i) * 2048 + c4); \
        _Pragma("unroll") for (int i = 0; i < 2; ++i) { ql[i] = *(const GAS u32x4*)(QH + base_ + (size_t)(r2 + 32 * i) * 2048 + c8); vl[i] = *(const GAS u32x4*)(HI + base_ + (size_t)(r2 + 32 * i) * 2048 + c8); } } while (0)
    HGP_LOAD(c0);
#pragma unroll 1
    for (int jc = 0; jc < 4; ++jc) {
    const int c = c0 + jc, unit = bh * 32 + c;
    __syncthreads();
#pragma unroll
    for (int i = 0; i < 4; ++i) *(LAS f32x4*)(lds + P_G + ((r + 16 * i) * 132 + c4) * 4) = gl[i];
#pragma unroll
    for (int i = 0; i < 2; ++i) { *(LAS u32x4*)(lds + P_QS + ((r2 + 32 * i) * 136 + c8) * 2) = ql[i]; *(LAS u32x4*)(lds + P_VS + ((r2 + 32 * i) * 136 + c8) * 2) = vl[i]; }
    if (jc < 3) HGP_LOAD(c + 1);
    __syncthreads();
    float cs[16], kin[16], qf[16]; unsigned short vv[16];
    { float run = 0.f;
#pragma unroll
      for (int i = 0; i < 16; ++i) { const float g = *(const LAS float*)(lds + P_G + ((seg * 16 + i) * 132 + kk) * 4); run += g; cs[i] = run; kin[i] = 1.f - __expf(g);
          qf[i] = __uint_as_float(((unsigned)*(const LAS unsigned short*)(lds + P_QS + ((seg * 16 + i) * 136 + kk) * 2)) << 16);
          vv[i] = *(const LAS unsigned short*)(lds + P_VS + ((seg * 16 + i) * 136 + kk) * 2); } }
    TOT[seg * 128 + kk] = cs[15];
    { u32x4 v0, v1;
      v0.x = (unsigned)vv[0] | ((unsigned)vv[1] << 16); v0.y = (unsigned)vv[2] | ((unsigned)vv[3] << 16); v0.z = (unsigned)vv[4] | ((unsigned)vv[5] << 16); v0.w = (unsigned)vv[6] | ((unsigned)vv[7] << 16);
      v1.x = (unsigned)vv[8] | ((unsigned)vv[9] << 16); v1.y = (unsigned)vv[10] | ((unsigned)vv[11] << 16); v1.z = (unsigned)vv[12] | ((unsigned)vv[13] << 16); v1.w = (unsigned)vv[14] | ((unsigned)vv[15] << 16);
      GAS u32x4* dst = (GAS u32x4*)(SVA + (size_t)unit * (CH_VT + CH_AS) + kk * 128 + seg * 32); dst[0] = v0; dst[1] = v1; }
    __syncthreads();
    { const float t0 = TOT[kk], t1 = TOT[128 + kk], t2 = TOT[256 + kk], t3 = TOT[384 + kk];
      const float pre = (seg > 0 ? t0 : 0.f) + (seg > 1 ? t1 : 0.f) + (seg > 2 ? t2 : 0.f), bl = (t0 + t1) + (t2 + t3), dl = __expf(fmaxf(bl, -85.f));
      unsigned short kh[16];
#pragma unroll
      for (int i = 0; i < 16; ++i) { const float bb = fmaxf(pre + cs[i], -85.f); const float e = __expf(bb), ei = __expf(-bb);
          *(LAS unsigned short*)(lds + P_QT + (seg * 16 + i) * PQ + kk * 2) = cvt1(qf[i] * e);
          *(LAS unsigned short*)(lds + P_KT + (seg * 16 + i) * PQ + kk * 2) = cvt1(kin[i] * ei);
          kh[i] = cvt1(kin[i] * fminf(ei * dl, 1.f)); }
      u32x4 k0, k1;
      k0.x = (unsigned)kh[0] | ((unsigned)kh[1] << 16); k0.y = (unsigned)kh[2] | ((unsigned)kh[3] << 16); k0.z = (unsigned)kh[4] | ((unsigned)kh[5] << 16); k0.w = (unsigned)kh[6] | ((unsigned)kh[7] << 16);
      k1.x = (unsigned)kh[8] | ((unsigned)kh[9] << 16); k1.y = (unsigned)kh[10] | ((unsigned)kh[11] << 16); k1.z = (unsigned)kh[12] | ((unsigned)kh[13] << 16); k1.w = (unsigned)kh[14] | ((unsigned)kh[15] << 16);
      GAS u32x4* dst = (GAS u32x4*)(SQK + (size_t)unit * (CH_QT + CH_KH) + CH_QT + kk * 128 + seg * 32); dst[0] = k0; dst[1] = k1;
      if (seg == 0) SD[(size_t)unit * 128 + kk] = dl; }
    __syncthreads();
#pragma unroll
    for (int i = 0; i < 2; ++i) { const int ch = tid + 512 * i, r = ch >> 4, cc = ch & 15;
        *(GAS u32x4*)(SQK + (size_t)unit * (CH_QT + CH_KH) + ch * 16) = *(const LAS u32x4*)(lds + P_QT + r * PQ + cc * 16); }
    bf16x8 bq[4];
#pragma unroll
    for (int ks = 0; ks < 4; ++ks) bq[ks] = *(const LAS bf16x8*)(lds + P_QT + (16 * tt + l15) * PQ + ks * 64 + q4 * 16);
#pragma unroll
    for (int j = 0; j < 2; ++j) {
        const int st = 2 * vh + j;
        f32x4 a = (f32x4){0.f, 0.f, 0.f, 0.f};
        if (st <= tt) {
#pragma unroll
            for (int ks = 0; ks < 4; ++ks) a = HG_MFMA(*(const LAS bf16x8*)(lds + P_KT + (16 * st + l15) * PQ + ks * 64 + q4 * 16), bq[ks], a);
            if (st == tt) {
#pragma unroll
                for (int r = 0; r < 4; ++r) if (4 * q4 + r > l15) a[r] = 0.f;
            }
        }
        *(GAS unsigned long long*)(SVA + (size_t)unit * (CH_VT + CH_AS) + CH_VT + ((16 * tt + l15) * 64 + 16 * st + 4 * q4) * 2) = (unsigned long long)cvtpk(a[0], a[1]) | ((unsigned long long)cvtpk(a[2], a[3]) << 32);
    }
    }
#undef HGP_LOAD
}

constexpr int C_QT = 0, C_KH = 17408, C_VT = 35840, C_AS = 54272, C_D = 63488, C_ST = 64000, C_XS = 98816, C_NEED = C_XS + 512;
__device__ __forceinline__ void hgrn_chain(LAS unsigned char* lds, const unsigned char* SQK, const unsigned char* SVA, const float* SD, const bf16* GS, const float* gn, bf16* OB, int bh, int tid) {
    const int lane = tid & 63, w = __builtin_amdgcn_readfirstlane(tid >> 6), l15 = lane & 15, q4 = lane >> 4;
    const int tt = w >> 1, vh = w & 1;
    const int b = bh >> 4, h = bh & 15;
    LAS float* DD = (LAS float*)(lds + C_D); LAS float* XS = (LAS float*)(lds + C_XS);
    __syncthreads();
    for (int i = tid; i < 128 * PQ / 16; i += 512) ((LAS u32x4*)(lds + C_ST))[i] = (u32x4){0u, 0u, 0u, 0u};
    f32x4 Sacc[8];
#pragma unroll
    for (int i = 0; i < 8; ++i) Sacc[i] = (f32x4){0.f, 0.f, 0.f, 0.f};
    const size_t base = (size_t)b * 2048 * 2048 + h * 128;
    float gnv[4];
#pragma unroll
    for (int vt = 0; vt < 4; ++vt) gnv[vt] = gn[16 * (4 * vh + vt) + l15];
    u32x4 sq[2], sk[2], sv[2], sa, sd;
#define HG_STAGE_LOAD(c) do { const size_t u_ = (size_t)(bh * 32 + (c)); const GAS u32x4* pqk = (const GAS u32x4*)(SQK + u_ * (CH_QT + CH_KH)); const GAS u32x4* pva = (const GAS u32x4*)(SVA + u_ * (CH_VT + CH_AS)); \
        sq[0] = pqk[tid]; sq[1] = pqk[tid + 512]; sk[0] = pqk[1024 + tid]; sk[1] = pqk[1536 + tid]; sv[0] = pva[tid]; sv[1] = pva[tid + 512]; sa = pva[1024 + tid]; \
        if (tid < 32) sd = ((const GAS u32x4*)(SD + u_ * 128))[tid]; } while (0)
#define HG_STAGE_STORE() do { \
        _Pragma("unroll") for (int i = 0; i < 2; ++i) { const int ch = tid + 512 * i; \
            *(LAS u32x4*)(lds + C_QT + (ch >> 4) * PQ + (ch & 15) * 16) = sq[i]; *(LAS u32x4*)(lds + C_KH + (ch >> 3) * PS + (ch & 7) * 16) = sk[i]; *(LAS u32x4*)(lds + C_VT + (ch >> 3) * PS + (ch & 7) * 16) = sv[i]; } \
        *(LAS u32x4*)(lds + C_AS + (tid >> 3) * PS + (tid & 7) * 16) = sa; if (tid < 32) ((LAS u32x4*)(lds + C_D))[tid] = sd; } while (0)
    HG_STAGE_LOAD(0);
    HG_STAGE_STORE();
    for (int c = 0; c < 32; ++c) {
        __syncthreads();
        unsigned short gsv[4][4];
        { const size_t o_ = base + (size_t)(c * 64 + 16 * tt + 4 * q4) * 2048 + 64 * vh + l15;
#pragma unroll
          for (int vt = 0; vt < 4; ++vt)
#pragma unroll
              for (int r = 0; r < 4; ++r) gsv[vt][r] = GS[o_ + (size_t)r * 2048 + 16 * vt]; }
        if (c + 1 < 32) HG_STAGE_LOAD(c + 1);
        f32x4 oacc[4];
#pragma unroll
        for (int vt = 0; vt < 4; ++vt) oacc[vt] = (f32x4){0.f, 0.f, 0.f, 0.f};
#pragma unroll
        for (int ks = 0; ks < 4; ++ks) { const bf16x8 aq = *(const LAS bf16x8*)(lds + C_QT + (16 * tt + l15) * PQ + ks * 64 + q4 * 16);
#pragma unroll
            for (int vt = 0; vt < 4; ++vt) oacc[vt] = HG_MFMA(aq, *(const LAS bf16x8*)(lds + C_ST + (16 * (4 * vh + vt) + l15) * PQ + ks * 64 + q4 * 16), oacc[vt]); }
#pragma unroll
        for (int ks = 0; ks < 2; ++ks) { const bf16x8 aa = *(const LAS bf16x8*)(lds + C_AS + (16 * tt + l15) * PS + ks * 64 + q4 * 16);
#pragma unroll
            for (int vt = 0; vt < 4; ++vt) oacc[vt] = HG_MFMA(aa, *(const LAS bf16x8*)(lds + C_VT + (16 * (4 * vh + vt) + l15) * PS + ks * 64 + q4 * 16), oacc[vt]); }
        { const bf16x8 bv0 = *(const LAS bf16x8*)(lds + C_VT + (16 * w + l15) * PS + q4 * 16), bv1 = *(const LAS bf16x8*)(lds + C_VT + (16 * w + l15) * PS + 64 + q4 * 16);
#pragma unroll
          for (int kt = 0; kt < 8; ++kt) { const f32x4 d = *(const LAS f32x4*)(lds + C_D + (16 * kt + 4 * q4) * 4); Sacc[kt] = Sacc[kt] * d;
              Sacc[kt] = HG_MFMA(*(const LAS bf16x8*)(lds + C_KH + (16 * kt + l15) * PS + q4 * 16), bv0, Sacc[kt]);
              Sacc[kt] = HG_MFMA(*(const LAS bf16x8*)(lds + C_KH + (16 * kt + l15) * PS + 64 + q4 * 16), bv1, Sacc[kt]); } }
        { float ss[4];
#pragma unroll
          for (int r = 0; r < 4; ++r) { ss[r] = (oacc[0][r] * oacc[0][r] + oacc[1][r] * oacc[1][r]) + (oacc[2][r] * oacc[2][r] + oacc[3][r] * oacc[3][r]);
              ss[r] += __shfl_xor(ss[r], 1); ss[r] += __shfl_xor(ss[r], 2); ss[r] += __shfl_xor(ss[r], 4); ss[r] += __shfl_xor(ss[r], 8); }
          if (l15 == 0) {
#pragma unroll
              for (int r = 0; r < 4; ++r) XS[(16 * tt + 4 * q4 + r) * 2 + vh] = ss[r]; } }
        __syncthreads();
#pragma unroll
        for (int kt = 0; kt < 8; ++kt)
            *(LAS unsigned long long*)(lds + C_ST + (16 * w + l15) * PQ + (16 * kt + 4 * q4) * 2) = (unsigned long long)cvtpk(Sacc[kt][0], Sacc[kt][1]) | ((unsigned long long)cvtpk(Sacc[kt][2], Sacc[kt][3]) << 32);
        if (c + 1 < 32) HG_STAGE_STORE();
        { const size_t o_ = base + (size_t)(c * 64 + 16 * tt + 4 * q4) * 2048 + 64 * vh + l15;
#pragma unroll
          for (int r = 0; r < 4; ++r) { const int t = 16 * tt + 4 * q4 + r; const float rs = 1.f / sqrtf((XS[2 * t] + XS[2 * t + 1]) * (1.f / 128.f) + LN_EPS);
#pragma unroll
              for (int vt = 0; vt < 4; ++vt) OB[o_ + (size_t)r * 2048 + 16 * vt] = cvt1(oacc[vt][r] * rs * gnv[vt] * __uint_as_float(((unsigned)gsv[vt][r]) << 16)); } }
    }
#undef HG_STAGE_LOAD
#undef HG_STAGE_STORE
}
#undef HG_MFMA
}

struct Frame {
    LAS unsigned char* lds;
    volatile LAS unsigned* MISC;
    gu32* ctl;
    int tid, lane, wave, vcu, G;
};
__device__ __forceinline__ float wave_sum(float v) {
#pragma unroll
    for (int o = 1; o < 64; o <<= 1) v += __shfl_xor(v, o);
    return v;
}
__device__ __forceinline__ float bf2f(bf16 h) { return __uint_as_float(((unsigned)h) << 16); }
__device__ __forceinline__ float bflo(unsigned w) { return __uint_as_float(w << 16); }
__device__ __forceinline__ float bfhi(unsigned w) { return __uint_as_float(w & 0xffff0000u); }

struct TrItem { const float* W; bf16* WT; int K, N, k0, n0, rmtype, rmarg; float scale; };
__device__ __forceinline__ int tr_rowmap(int rmtype, int rmarg, int n) {
    if (rmtype == 0) return n + rmarg;
    if (rmtype == 1) { if (n < 1536) return n; if (n < 1600) { const int i = n - 1536; return 1536 + ((i & 31) << 1) + (i >> 5); } return n + 192; }
    if (rmtype == 2) { const int hd = n / 192, w = n - hd * 192; if (w < 128) return n; const int i = w - 128; return hd * 192 + 128 + ((i & 31) << 1) + (i >> 5); }
    return ((n >> 7) << 8) + (n & 127) + rmarg;
}
__device__ __forceinline__ void tr_load(const TrItem& T, f32x4 (&v)[16], int lane) {
    const float* p = T.W + (size_t)(T.k0 + 4 * (lane >> 4)) * T.N + T.n0 + 4 * (lane & 15);
#pragma unroll
    for (int j = 0; j < 4; ++j)
#pragma unroll
        for (int r = 0; r < 4; ++r) v[4 * j + r] = *(const GAS f32x4*)(p + (size_t)(16 * j + r) * T.N);
}
__device__ __forceinline__ void tr_store(const TrItem& T, const f32x4 (&v)[16], LAS unsigned char* scr, int lane) {
    const int kq = lane >> 4, i16 = lane & 15;
#pragma unroll
    for (int j = 0; j < 4; ++j) {
        const int c = 2 * j + (kq >> 1), half = kq & 1;
#pragma unroll
        for (int ns = 0; ns < 4; ++ns) {
            const int n = 4 * i16 + ns;
            const unsigned lo = att::cvtpk(v[4 * j][ns] * T.scale, v[4 * j + 1][ns] * T.scale), hi = att::cvtpk(v[4 * j + 2][ns] * T.scale, v[4 * j + 3][ns] * T.scale);
            *(LAS unsigned long long*)(scr + n * 128 + ((c ^ (i16 & 7)) << 4) + half * 8) = (unsigned long long)lo | ((unsigned long long)hi << 32);
        }
    }
    LDS_WAIT(); asm volatile("" ::: "memory");
#pragma unroll
    for (int jj = 0; jj < 8; ++jj) {
        const int n = (lane >> 3) + 8 * jj, c = lane & 7;
        const v4u o = *(const LAS v4u*)(scr + n * 128 + ((c ^ ((n >> 2) & 7)) << 4));
        const int nd = tr_rowmap(T.rmtype, T.rmarg, T.n0 + n);
        *(GAS v4u*)(T.WT + ((size_t)((nd >> 8) * (T.K >> 6) + (T.k0 >> 6)) * 256 + (nd & 255)) * 64 + 8 * c) = o;
    }
    LDS_WAIT(); asm volatile("" ::: "memory");
}

template <bool WF32, bool WBF, bool WST>
__device__ __forceinline__ void ln_row(const float* xrow, const float* g, const float* b, float* of, bf16* ob, float* st, int lane) {
    const GAS f32x4* xr = (const GAS f32x4*)xrow + lane;
    f32x4 v[16]; float s = 0.f;
#pragma unroll
    for (int j = 0; j < 16; ++j) { v[j] = xr[64 * j]; s += (v[j].x + v[j].y) + (v[j].z + v[j].w); }
    const float mean = wave_sum(s) * (1.f / 4096.f); float s2 = 0.f;
#pragma unroll
    for (int j = 0; j < 16; ++j) { v[j] = v[j] - mean; s2 += (v[j].x * v[j].x + v[j].y * v[j].y) + (v[j].z * v[j].z + v[j].w * v[j].w); }
    const float rstd = 1.f / sqrtf(wave_sum(s2) * (1.f / 4096.f) + LN_EPS);
    if (WST) { if (lane == 0) { st[0] = mean; st[1] = rstd; } }
    const GAS f32x4* gr = (const GAS f32x4*)g + lane; const GAS f32x4* br = (const GAS f32x4*)b + lane;
#pragma unroll
    for (int j = 0; j < 16; ++j) { const f32x4 o = v[j] * rstd * gr[64 * j] + br[64 * j];
        if (WF32) ((GAS f32x4*)of)[lane + 64 * j] = o;
        if (WBF) ((GAS unsigned long long*)ob)[lane + 64 * j] = (unsigned long long)pk2(o.x, o.y) | ((unsigned long long)pk2(o.z, o.w) << 32); }
}

struct Args { const void* in[21]; float* out; unsigned char* ws; int ph_lo, ph_hi; };
__global__ void __launch_bounds__(NWAVES * 64, 2) mega_fwd(Args args) {
    extern __shared__ __attribute__((aligned(16))) unsigned char lds[];
    Frame F;
    F.lds = (LAS unsigned char*)lds;
    F.MISC = (volatile LAS unsigned*)(F.lds + MISC_OFF);
    F.tid = threadIdx.x; F.lane = F.tid & 63; F.wave = __builtin_amdgcn_readfirstlane(F.tid >> 6);
    F.G = gridDim.x; { const int bx = blockIdx.x; F.vcu = (F.G % 8 == 0) ? (bx % 8) * (F.G / 8) + bx / 8 : bx; }
    unsigned char* ws = args.ws;
    F.ctl = (gu32*)(ws + WS_CTL);
    const float* x = (const float*)args.in[0]; const int* positions = (const int*)args.in[1];
    const float* ln_in_g = (const float*)args.in[2]; const float* ln_in_b = (const float*)args.in[3];
    const float* w_in = (const float*)args.in[4]; const float* q_norm_g = (const float*)args.in[5]; const float* w_uq = (const float*)args.in[6];
    const float* kv_norm_g = (const float*)args.in[7]; const float* w_ukv = (const float*)args.in[8]; const float* hg_lb = (const float*)args.in[9];
    const float* hg_norm_g = (const float*)args.in[10]; const float* w_a = (const float*)args.in[11]; const float* w_b = (const float*)args.in[12];
    const float* w_out = (const float*)args.in[13]; const float* ln1_g = (const float*)args.in[14]; const float* ln1_b = (const float*)args.in[15];
    const float* w_gate = (const float*)args.in[16]; const float* w_up = (const float*)args.in[17]; const float* w_down = (const float*)args.in[18];
    const float* ln2_g = (const float*)args.in[19]; const float* ln2_b = (const float*)args.in[20];
    float* out = args.out;
    bf16* Wt_in = (bf16*)(ws + WS_WIN); bf16* Wt_uq = (bf16*)(ws + WS_WUQ); bf16* Wt_ukv = (bf16*)(ws + WS_WUKV); bf16* Wt_ab = (bf16*)(ws + WS_WAB);
    bf16* Wt_out = (bf16*)(ws + WS_WOUT); bf16* Wt_gu = (bf16*)(ws + WS_WGU); bf16* Wt_down = (bf16*)(ws + WS_WDOWN);
    bf16* HB = (bf16*)(ws + WS_HB); float* CS = (float*)(ws + WS_CS); float* ST = (float*)(ws + WS_ST);
    float* CF = (float*)(ws + WS_CF); bf16* QH = (bf16*)(ws + WS_QH); float* GL = (float*)(ws + WS_G); bf16* HI = (bf16*)(ws + WS_HI); bf16* GS = (bf16*)(ws + WS_GS);
    bf16* GA = (bf16*)(ws + WS_GA); bf16* GB = (bf16*)(ws + WS_GB);
    bf16* Q = (bf16*)(ws + WS_Q); bf16* KV = (bf16*)(ws + WS_KV); bf16* CQN = (bf16*)(ws + WS_CQN); bf16* CKVN = (bf16*)(ws + WS_CKVN); bf16* KROPE = (bf16*)(ws + WS_KROPE);
    unsigned char* SQK = ws + WS_HB; unsigned char* SVA = ws + WS_CF; float* SD = (float*)(ws + WS_CF + 48 * MiB);
    bf16* OAB = (bf16*)(ws + WS_OAB); bf16* MERGED = (bf16*)(ws + WS_KV); float* R = (float*)(ws + WS_R); bf16* ACT = (bf16*)(ws + WS_ACT);

    for (int u = F.tid; u < (LDS_BYTES - LDSCTL_OFF) / 4; u += NWAVES * 64) ((LAS unsigned*)(F.lds + LDSCTL_OFF))[u] = 0u;
    __syncthreads();
#if MK_ONE_LAUNCH
    XcdBarrier bar = xcd_barrier_post((unsigned*)(F.ctl + CW_BAR), F.MISC + 8);
#define GRID_BAR() xcd_barrier(bar)
#else
#define GRID_BAR() do {} while (0)
#endif
    const int lo = args.ph_lo, hi = args.ph_hi;
#define IN(k) (lo <= (k) && (k) < hi)
#define BOTH(k) (IN(k) && IN((k) + 1))
    const int gw = F.vcu * NWAVES + F.wave, NGW = F.G * NWAVES;
    const int gt = blockIdx.x * (NWAVES * 64) + F.tid, NGT = F.G * NWAVES * 64;

    if (IN(0))
_Pragma("unroll 1")
    for (int rep = 0; rep < (PROBE_REP == 0 ? 2 : 1); ++rep) {
        LAS unsigned char* scr = F.lds + RING_OFF + F.wave * 8192;
        constexpr int I_IN = (DM / 64) * (17984 / 64), I_UQ = (1024 / 64) * (3072 / 64), I_UKV = (512 / 64) * (4096 / 64), I_A = (2048 / 64) * (4096 / 64), I_B = I_A,
                      I_OUT = (4096 / 64) * (4096 / 64), I_G = (4096 / 64) * (DFF / 64), I_U = I_G, I_D = (DFF / 64) * (4096 / 64);
        constexpr int NITEMS = I_IN + I_UQ + I_UKV + I_A + I_B + I_OUT + I_G + I_U + I_D;
#define TR_DECODE(T, item) do { int r_ = (item); \
            if (r_ < I_IN) { T = TrItem{w_in, Wt_in, DM, 17984, 0, 0, 1, 0, 1.f}; } else { r_ -= I_IN; \
            if (r_ < I_UQ) { T = TrItem{w_uq, Wt_uq, 1024, 3072, 0, 0, 2, 0, QSCALE}; } else { r_ -= I_UQ; \
            if (r_ < I_UKV) { T = TrItem{w_ukv, Wt_ukv, 512, 4096, 0, 0, 0, 0, 1.f}; } else { r_ -= I_UKV; \
            if (r_ < I_A) { T = TrItem{w_a, Wt_ab, 2048, 4096, 0, 0, 0, 0, 1.f}; } else { r_ -= I_A; \
            if (r_ < I_B) { T = TrItem{w_b, Wt_ab, 2048, 4096, 0, 0, 0, 4096, 1.f}; } else { r_ -= I_B; \
            if (r_ < I_OUT) { T = TrItem{w_out, Wt_out, 4096, 4096, 0, 0, 0, 0, 1.f}; } else { r_ -= I_OUT; \
            if (r_ < I_G) { T = TrItem{w_gate, Wt_gu, 4096, DFF, 0, 0, 3, 0, 1.f}; } else { r_ -= I_G; \
            if (r_ < I_U) { T = TrItem{w_up, Wt_gu, 4096, DFF, 0, 0, 3, 128, 1.f}; } else { r_ -= I_U; \
            T = TrItem{w_down, Wt_down, DFF, 4096, 0, 0, 0, 0, 1.f}; } } } } } } } } \
              \
            const int kbt_ = T.K / 64, nblk_ = T.N / 64, grp_ = r_ / (64 * nblk_), rem_ = r_ - grp_ * 64 * nblk_, gk_ = (kbt_ - 64 * grp_) < 64 ? (kbt_ - 64 * grp_) : 64; \
            T.k0 = 64 * (64 * grp_ + rem_ % gk_); T.n0 = 64 * (rem_ / gk_); } while (0)
        if (gw < NITEMS) {
            TrItem Ta, Tb; f32x4 va[16], vb[16];
            int it = gw;
            TR_DECODE(Ta, it); tr_load(Ta, va, F.lane);
            for (;;) {
                const int itb = it + NGW; const bool hb = itb < NITEMS;
                { const int idx = hb ? itb : it; TR_DECODE(Tb, idx); tr_load(Tb, vb, F.lane); }
                tr_store(Ta, va, scr, F.lane);
                if (!hb) break;
                const int ita = itb + NGW; const bool ha = ita < NITEMS;
                { const int idx = ha ? ita : itb; TR_DECODE(Ta, idx); tr_load(Ta, va, F.lane); }
                tr_store(Tb, vb, scr, F.lane);
                if (!ha) break;
                it = ita;
            }
        }
#if defined(PROBE_X)
        {
            unsigned accx = 0u;
#if PROBE_X == 1
            for (int it = gw; it < NITEMS; it += NGW) { TrItem Tx; TR_DECODE(Tx, it); f32x4 vx[16]; tr_load(Tx, vx, F.lane);
#pragma unroll
                for (int i = 0; i < 16; ++i) accx ^= __float_as_uint(vx[i].x) ^ __float_as_uint(vx[i].y) ^ __float_as_uint(vx[i].z) ^ __float_as_uint(vx[i].w); }
#elif PROBE_X == 2
            { const GAS v4u* src = (const GAS v4u*)w_in; const size_t n16 = (size_t)DM * 17984 / 4;
              for (size_t i = gt; i < n16; i += (size_t)NGT * 4) { v4u a = src[i]; v4u b = (i + NGT < n16) ? src[i + NGT] : a; v4u c = (i + 2 * (size_t)NGT < n16) ? src[i + 2 * (size_t)NGT] : a; v4u d = (i + 3 * (size_t)NGT < n16) ? src[i + 3 * (size_t)NGT] : a;
                  accx ^= a.x ^ a.y ^ a.z ^ a.w ^ b.x ^ b.y ^ b.z ^ b.w ^ c.x ^ c.y ^ c.z ^ c.w ^ d.x ^ d.y ^ d.z ^ d.w; } }
#elif PROBE_X == 3
            { GAS v4u* dst = (GAS v4u*)(ws + WS_CF); const size_t n16 = (size_t)295 * MiB / 16;
              for (size_t i = gt; i < n16; i += NGT) dst[i] = (v4u){0u, 0u, 0u, 0u}; }
#endif
            if (accx == 0x12345679u) CS[0] = 1.f;
        }
#endif
#undef TR_DECODE
        for (int i = gt; i < 64 * 192 * 8; i += NGT) { const int t = i / (192 * 8), rr = i - t * (192 * 8);
            ((GAS v4u*)(Wt_in + ((size_t)(6 * 64 + t) * 256 + 64) * 64))[rr] = (v4u){0u, 0u, 0u, 0u}; }
        for (int m = gw; m < MTOK; m += NGW) ln_row<false, true, true>(x + (size_t)m * DM, ln_in_g, ln_in_b, nullptr, HB + (size_t)m * LDH, ST + 2 * m, F.lane);
        for (int i = gt; i < MTOK * 32; i += NGT) { const int row = i >> 5, k = i & 31;
            const float inv = exp2f(-(float)k * (13.287712379549449f / 32.f)); const float ang = (float)positions[row] * inv;
            CS[(size_t)row * 64 + k] = cosf(ang); CS[(size_t)row * 64 + 32 + k] = sinf(ang); }
        if (BOTH(0)) GRID_BAR();
    }
    if (IN(1))
_Pragma("unroll 1")
    for (int rep = 0; rep < (PROBE_REP == 1 ? 2 : 1); ++rep) {
        pg8::Gemm g{HB, Wt_in, MTOK, NPROJ, DM, LDH}; pg8::StaticOrder S; S.init(MTOK, NPROJ, F.G, (int)blockIdx.x);
        pg8::EpiProj E{CF, QH, GL, HI, GS, GA, GB, hg_lb};
        pg8::gemm_phase<pg8::EpiProj, pg8::StaticOrder, true, true>(F.lds + RING_OFF, g, S, E);
        if (BOTH(1)) GRID_BAR();
    }
    if (IN(2))
_Pragma("unroll 1")
    for (int rep = 0; rep < (PROBE_REP == 2 ? 2 : 1); ++rep) {
        for (int m = gw; m < MTOK; m += NGW) {
            const float* cf = CF + (size_t)m * 1792;
            { const GAS f32x4* p = (const GAS f32x4*)cf + F.lane; f32x4 v[4]; float s = 0.f;
#pragma unroll
              for (int j = 0; j < 4; ++j) { v[j] = p[64 * j]; s += (v[j].x * v[j].x + v[j].y * v[j].y) + (v[j].z * v[j].z + v[j].w * v[j].w); }
              const float rs = 1.f / sqrtf(wave_sum(s) * (1.f / 1024.f) + LN_EPS);
#pragma unroll
              for (int j = 0; j < 4; ++j) { const f32x4 gg = ((const GAS f32x4*)q_norm_g)[F.lane + 64 * j]; const f32x4 o = v[j] * rs * gg;
                  ((GAS unsigned long long*)(CQN + (size_t)m * 1024))[F.lane + 64 * j] = (unsigned long long)pk2(o.x, o.y) | ((unsigned long long)pk2(o.z, o.w) << 32); } }
            { const GAS f32x4* p = (const GAS f32x4*)(cf + 1024) + F.lane; f32x4 v[2]; float s = 0.f;
#pragma unroll
              for (int j = 0; j < 2; ++j) { v[j] = p[64 * j]; s += (v[j].x * v[j].x + v[j].y * v[j].y) + (v[j].z * v[j].z + v[j].w * v[j].w); }
              const float rs = 1.f / sqrtf(wave_sum(s) * (1.f / 512.f) + LN_EPS);
#pragma unroll
              for (int j = 0; j < 2; ++j) { const f32x4 gg = ((const GAS f32x4*)kv_norm_g)[F.lane + 64 * j]; const f32x4 o = v[j] * rs * gg;
                  ((GAS unsigned long long*)(CKVN + (size_t)m * 512))[F.lane + 64 * j] = (unsigned long long)pk2(o.x, o.y) | ((unsigned long long)pk2(o.z, o.w) << 32); } }
            if (F.lane < 32) { const float x1 = cf[1536 + 2 * F.lane], x2 = cf[1536 + 2 * F.lane + 1], c = CS[(size_t)m * 64 + F.lane], s = CS[(size_t)m * 64 + 32 + F.lane];
                ((GAS unsigned*)(KROPE + (size_t)m * 64))[F.lane] = pk2(x1 * c - x2 * s, x1 * s + x2 * c); }
        }
        if (BOTH(2)) GRID_BAR();
    }
    if (IN(3))
_Pragma("unroll 1")
    for (int rep = 0; rep < (PROBE_REP == 3 ? 2 : 1); ++rep) {
        { pg8::Gemm g{CQN, Wt_uq, MTOK, 3072, 1024, 1024}; pg8::StaticOrder S; S.init(MTOK, 3072, F.G, (int)blockIdx.x);
          pg8::EpiQ E{Q, CS};
          pg8::gemm_phase<pg8::EpiQ, pg8::StaticOrder, true, true>(F.lds + RING_OFF, g, S, E); }
        { pg8::Gemm g{CKVN, Wt_ukv, MTOK, 4096, 512, 512}; pg8::StaticOrder S; S.init(MTOK, 4096, F.G, (int)blockIdx.x);
          pg8::EpiPlain E{KV, 4096};
          pg8::gemm_phase<pg8::EpiPlain, pg8::StaticOrder, true, true>(F.lds + RING_OFF, g, S, E); }
#if defined(PROBE_X) && PROBE_X == 4
        for (int pp = 0; pp < 2; ++pp)
#else
        const int pp = 0;
#endif
        for (;;) {
            __syncthreads();
            if (F.tid == 0) F.MISC[0] = __hip_atomic_fetch_add(F.ctl + CW_QUEUE2 + 64 * rep + 128 * pp, 1u, RLX_AGENT);
            __syncthreads();
            const unsigned idx = (unsigned)__builtin_amdgcn_readfirstlane((int)F.MISC[0]);
            if (idx >= 512u) break;
            hg::hgrn_prep(F.lds + RING_OFF, GL, QH, HI, SQK, SVA, SD, (int)(idx >> 3), (int)(idx & 7u) * 4, F.tid);
        }
        __syncthreads();
        if (BOTH(3)) GRID_BAR();
    }
    if (IN(4))
_Pragma("unroll 1")
    for (int rep = 0; rep < (PROBE_REP == 4 ? 2 : 1); ++rep) {
        for (;;) {
            __syncthreads();
            if (F.tid == 0) F.MISC[0] = __hip_atomic_fetch_add(F.ctl + CW_QUEUE + 64 * rep, 1u, RLX_AGENT);
            __syncthreads();
            const unsigned idx = (unsigned)__builtin_amdgcn_readfirstlane((int)F.MISC[0]);
            if (idx >= 576u) break;
            if (idx < 64u) hg::hgrn_chain(F.lds + RING_OFF, SQK, SVA, SD, GS, hg_norm_g, OAB + (size_t)MTOK * 2048, (int)idx, F.tid);
            else { const unsigned u = idx - 64u; const int qb = 7 - (int)(u >> 6), bh = (int)(u & 63u);
                att::attn_unit(F.lds + RING_OFF, Q, KV, KROPE, OAB, bh >> 4, bh & 15, qb, F.tid); }
        }
        __syncthreads();
        if (BOTH(4)) GRID_BAR();
    }
    if (IN(5))
_Pragma("unroll 1")
    for (int rep = 0; rep < (PROBE_REP == 5 ? 2 : 1); ++rep) {
        pg8::Gemm g{OAB, Wt_ab, 2 * MTOK, 8192, 2048, 2048}; pg8::DualOrder S; S.S.init(MTOK, 4096, F.G, (int)blockIdx.x);
        pg8::EpiMerge E{GA, GB, MERGED};
        pg8::gemm_phase<pg8::EpiMerge, pg8::DualOrder, true, true>(F.lds + RING_OFF, g, S, E);
        if (BOTH(5)) GRID_BAR();
    }
    if (IN(6))
_Pragma("unroll 1")
    for (int rep = 0; rep < (PROBE_REP == 6 ? 2 : 1); ++rep) {
        pg8::Gemm g{MERGED, Wt_out, MTOK, 4096, 4096, 4096}; pg8::StaticOrder S; S.init(MTOK, 4096, F.G, (int)blockIdx.x);
        pg8::EpiMix E{x, ST, ln_in_g, ln_in_b, R, ALPHA};
        pg8::gemm_phase<pg8::EpiMix, pg8::StaticOrder, true, true>(F.lds + RING_OFF, g, S, E);
        if (BOTH(6)) GRID_BAR();
    }
    if (IN(7)) {
        for (int m = gw; m < MTOK; m += NGW) ln_row<true, true, false>(R + (size_t)m * DM, ln1_g, ln1_b, R + (size_t)m * DM, HB + (size_t)m * LDH, nullptr, F.lane);
        if (BOTH(7)) GRID_BAR();
    }
    if (IN(8))
_Pragma("unroll 1")
    for (int rep = 0; rep < (PROBE_REP == 8 ? 2 : 1); ++rep) {
        pg8::Gemm g{HB, Wt_gu, MTOK, 2 * DFF, DM, LDH}; pg8::StaticOrder S; S.init(MTOK, 2 * DFF, F.G, (int)blockIdx.x);
        pg8::EpiSwiglu E{ACT};
        pg8::gemm_phase<pg8::EpiSwiglu, pg8::StaticOrder, true, true>(F.lds + RING_OFF, g, S, E);
        if (BOTH(8)) GRID_BAR();
    }
    if (IN(9))
_Pragma("unroll 1")
    for (int rep = 0; rep < (PROBE_REP == 9 ? 2 : 1); ++rep) {
        pg8::Gemm g{ACT, Wt_down, MTOK, 4096, DFF, DFF}; pg8::StaticOrder S; S.init(MTOK, 4096, F.G, (int)blockIdx.x);
        pg8::EpiDown E{R, out, ALPHA};
        pg8::gemm_phase<pg8::EpiDown, pg8::StaticOrder, true, true>(F.lds + RING_OFF, g, S, E);
        if (BOTH(9)) GRID_BAR();
    }
    if (IN(10)) {
        for (int m = gw; m < MTOK; m += NGW) ln_row<true, false, false>(out + (size_t)m * DM, ln2_g, ln2_b, out + (size_t)m * DM, nullptr, nullptr, F.lane);
    }
#undef IN
#undef BOTH
}

extern "C" void kernel_launch(void* const* d_in, const int* in_sizes, int n_in, void* d_out, int out_size, void* d_ws, size_t ws_size, hipStream_t stream) {
    static int grid = 0;
    if (grid == 0) {
        if (n_in != 21 || out_size != MTOK * DM || ws_size < WS_END) { fprintf(stderr, "kernel_launch: unexpected shapes (n_in %d, out %d, ws %zu, need %zu)\n", n_in, out_size, ws_size, (size_t)WS_END); grid = -1; return; }
        int dev = 0, cus = 0, per_cu = 0;
        if (hipGetDevice(&dev) != hipSuccess || hipDeviceGetAttribute(&cus, hipDeviceAttributeMultiprocessorCount, dev) != hipSuccess) { grid = -1; return; }
        if (hipFuncSetAttribute((const void*)mega_fwd, hipFuncAttributeMaxDynamicSharedMemorySize, LDS_BYTES) != hipSuccess) { fprintf(stderr, "kernel_launch: hipFuncSetAttribute failed\n"); grid = -1; return; }
        if (hipOccupancyMaxActiveBlocksPerMultiprocessor(&per_cu, (const void*)mega_fwd, NWAVES * 64, LDS_BYTES) != hipSuccess || per_cu < 1)
            fprintf(stderr, "kernel_launch: note: occupancy query reports %d workgroups per CU\n", per_cu);
        (void)hipGetLastError();
        grid = cus;
    }
    if (grid < 0) return;
    if (hipMemsetAsync((char*)d_ws + WS_CTL, 0, CTL_ZERO_BYTES, stream) != hipSuccess) return;
    Args a{};
    for (int i = 0; i < 21; ++i) a.in[i] = d_in[i];
    a.out = (float*)d_out; a.ws = (unsigned char*)d_ws;
#if MK_ONE_LAUNCH
    a.ph_lo = 0; a.ph_hi = NPHASE;
    hipLaunchKernelGGL(mega_fwd, dim3(grid), dim3(NWAVES * 64), LDS_BYTES, stream, a);
#else
    for (int p = 0; p < NPHASE; ++p) { a.ph_lo = p; a.ph_hi = p + 1; hipLaunchKernelGGL(mega_fwd, dim3(grid), dim3(NWAVES * 64), LDS_BYTES, stream, a); }
#endif
}
```
